# Optimizing an MI355X kernel written in HIP

```python
import jax, jax.numpy as jnp
from jax import lax
import numpy as np

D_MODEL = 2048
BATCH = 4
SEQ = 4096
DEPTH = 2

MIX_WIDTH = D_MODEL
FOURIER_WIDTH = MIX_WIDTH // 2
POOL_WIDTH = MIX_WIDTH - FOURIER_WIDTH
N_FOURIER_HEADS = 4
FOURIER_HEAD_DIM = FOURIER_WIDTH // N_FOURIER_HEADS
POOL_WINDOWS = (2, 4, 8, 16)
N_POOL_GROUPS = len(POOL_WINDOWS)
POOL_GROUP_DIM = POOL_WIDTH // N_POOL_GROUPS
N_EXPERTS = 16
CAPACITY_FACTOR = 2
D_EXPERT = D_MODEL
RMS_EPS = 1e-6

kernel_name = "fourier_pool_hybrid_ec_moe_encoder"


def rms_norm(x, g):
    xf = x.astype(jnp.float32)
    inv = lax.rsqrt(jnp.mean(xf * xf, axis=-1, keepdims=True) + RMS_EPS)
    return (xf * inv).astype(x.dtype) * g


def centred_pool_minus_identity(u, window):
    b, l, c = u.shape
    cs = jnp.concatenate([jnp.zeros((b, 1, c), u.dtype), jnp.cumsum(u, axis=1)], axis=1)
    t = jnp.arange(l)
    lo = jnp.clip(t - window // 2, 0, l)
    hi = jnp.clip(t + window - window // 2, 0, l)
    win_sum = jnp.take(cs, hi, axis=1) - jnp.take(cs, lo, axis=1)
    count = (hi - lo).astype(u.dtype)[None, :, None]
    return win_sum / count - u


def token_mixer(h, w_in, w_fourier, w_pool, pool_scale, w_out):
    b, l, _ = h.shape
    u = h @ w_in
    ua = u[..., :FOURIER_WIDTH].reshape(b, l, N_FOURIER_HEADS, FOURIER_HEAD_DIM)
    ub = u[..., FOURIER_WIDTH:].reshape(b, l, N_POOL_GROUPS, POOL_GROUP_DIM)
    fa = jnp.fft.fftn(ua.astype(jnp.float32), axes=(1, 3), norm="ortho").real.astype(h.dtype)
    ya = jnp.einsum('blgc,gcd->blgd', fa, w_fourier)
    pooled = jnp.stack(
        [centred_pool_minus_identity(ub[:, :, gi].astype(jnp.float32), w)
         for gi, w in enumerate(POOL_WINDOWS)], axis=2).astype(h.dtype)
    yb = jnp.einsum('blgc,gcd->blgd', pooled, w_pool) * pool_scale
    y = jnp.concatenate([ya.reshape(b, l, FOURIER_WIDTH), yb.reshape(b, l, POOL_WIDTH)], axis=-1)
    return y @ w_out


def expert_choice_ffn(h, w_router, w_gate, w_up, w_down):
    b, l, d = h.shape
    cap = CAPACITY_FACTOR * l // N_EXPERTS
    probs = jax.nn.softmax((h @ w_router).astype(jnp.float32), axis=-1)
    gates, idx = lax.top_k(jnp.swapaxes(probs, 1, 2), cap)
    flat = (idx + (jnp.arange(b) * l)[:, None, None]).reshape(-1)
    xs = jnp.take(h.reshape(b * l, d), flat, axis=0).reshape(b, N_EXPERTS, cap, d)
    hid = jax.nn.silu(jnp.einsum('becd,edf->becf', xs, w_gate)) * jnp.einsum('becd,edf->becf', xs, w_up)
    ys = jnp.einsum('becf,efd->becd', hid, w_down) * gates[..., None].astype(h.dtype)
    out = jnp.zeros((b * l, d), h.dtype).at[flat].add(ys.reshape(-1, d))
    return out.reshape(b, l, d)


def setup_inputs(seed: int = 0) -> dict:
    key = jax.random.key(seed)
    ks = jax.random.split(key, 14)
    f32 = jnp.float32
    def nrm(k, shape, fan_in):
        return jax.random.normal(k, shape, f32) * (fan_in ** -0.5)
    x = jax.random.normal(ks[0], (BATCH, SEQ, D_MODEL), f32)
    norm1_g = 1.0 + 0.02 * jax.random.normal(ks[1], (DEPTH, D_MODEL), f32)
    w_in = nrm(ks[2], (DEPTH, D_MODEL, MIX_WIDTH), D_MODEL)
    w_fourier = nrm(ks[3], (DEPTH, N_FOURIER_HEADS, FOURIER_HEAD_DIM, FOURIER_HEAD_DIM), FOURIER_HEAD_DIM)
    w_pool = nrm(ks[4], (DEPTH, N_POOL_GROUPS, POOL_GROUP_DIM, POOL_GROUP_DIM), POOL_GROUP_DIM)
    pool_scale = 1.0 + 0.02 * jax.random.normal(ks[5], (DEPTH, N_POOL_GROUPS, POOL_GROUP_DIM), f32)
    w_out = nrm(ks[6], (DEPTH, MIX_WIDTH, D_MODEL), MIX_WIDTH)
    norm2_g = 1.0 + 0.02 * jax.random.normal(ks[7], (DEPTH, D_MODEL), f32)
    w_router = nrm(ks[8], (DEPTH, D_MODEL, N_EXPERTS), D_MODEL)
    w_gate = nrm(ks[9], (DEPTH, N_EXPERTS, D_MODEL, D_EXPERT), D_MODEL)
    w_up = nrm(ks[10], (DEPTH, N_EXPERTS, D_MODEL, D_EXPERT), D_MODEL)
    w_down = nrm(ks[11], (DEPTH, N_EXPERTS, D_EXPERT, D_MODEL), D_EXPERT)
    final_g = 1.0 + 0.02 * jax.random.normal(ks[12], (D_MODEL,), f32)
    return {"x": x, "norm1_g": norm1_g, "w_in": w_in, "w_fourier": w_fourier,
            "w_pool": w_pool, "pool_scale": pool_scale, "w_out": w_out,
            "norm2_g": norm2_g, "w_router": w_router, "w_gate": w_gate,
            "w_up": w_up, "w_down": w_down, "final_g": final_g}


def reference(x, norm1_g, w_in, w_fourier, w_pool, pool_scale, w_out,
              norm2_g, w_router, w_gate, w_up, w_down, final_g):
    for layer in range(DEPTH):
        h = rms_norm(x, norm1_g[layer])
        x = x + token_mixer(h, w_in[layer], w_fourier[layer], w_pool[layer],
                            pool_scale[layer], w_out[layer])
        h = rms_norm(x, norm2_g[layer])
        x = x + expert_choice_ffn(h, w_router[layer], w_gate[layer], w_up[layer], w_down[layer])
    return rms_norm(x, final_g)
```

```cpp
#include <hip/hip_runtime.h>
#include <cstdio>
#include <cstdint>

#ifndef SHADOW
#define SHADOW 1
#endif
#ifndef REP
#define REP 0
#endif
#ifndef MK_PER_PHASE
#define MK_PER_PHASE 0
#endif

#define GAS __attribute__((address_space(1)))
#define LAS __attribute__((address_space(3)))
#define CAS __attribute__((address_space(4)))
typedef unsigned short bf16;
typedef short bf16x8 __attribute__((ext_vector_type(8)));
typedef float f32x4 __attribute__((ext_vector_type(4)));
typedef unsigned u32x4 __attribute__((ext_vector_type(4)));
typedef unsigned u32x2 __attribute__((ext_vector_type(2)));
typedef float f32x2 __attribute__((ext_vector_type(2)));

constexpr int NB = 4, SEQ = 4096, D = 2048, T = NB * SEQ, NL = 2, NE = 16, CAP = 512, ESL = NB * CAP  ;
constexpr int KH = 2048;
constexpr float RMS_EPS = 1e-6f;

constexpr size_t MiB = 1u << 20;
constexpr size_t WS_CTL = 0, CTL_ZERO_BYTES = 64 * 1024;
constexpr size_t WS_RMS1 = 1 * MiB;
constexpr size_t WS_RMS2 = WS_RMS1 + 64 * 1024;
constexpr size_t WS_WR   = WS_RMS2 + 64 * 1024;
constexpr size_t WS_CCS  = WS_WR + 128 * 1024;
constexpr size_t WS_SRS  = WS_CCS + 256 * 1024;
constexpr size_t WS_SGT  = WS_SRS + 128 * 1024;
constexpr size_t WS_ROFF = WS_SGT + 128 * 1024;
constexpr size_t WS_PROB = 2 * MiB;
constexpr size_t WS_SEL  = 3 * MiB;
constexpr size_t WS_WF   = 4 * MiB;
constexpr size_t WS_WPS  = 5 * MiB;
constexpr size_t WS_TT   = 6 * MiB;
constexpr size_t WS_WIN  = 16 * MiB;
constexpr size_t WS_WOT  = 32 * MiB;
constexpr size_t WS_WO2  = 48 * MiB;
constexpr size_t WS_NY   = 14 * MiB;
constexpr size_t WS_SS   = 264 * MiB;
constexpr size_t WS_CS   = 80 * MiB;
constexpr size_t WS_ZT   = 200 * MiB;
constexpr size_t WS_XB   = 136 * MiB;
constexpr size_t WS_UT   = 328 * MiB;
constexpr size_t WS_UP   = 360 * MiB;
constexpr size_t WS_F    = 392 * MiB;
constexpr size_t WS_HID  = 488 * MiB;
constexpr size_t WS_YS   = 616 * MiB;
constexpr size_t WS_XS   = 552 * MiB;
constexpr size_t WS_WGU  = 744 * MiB;
constexpr size_t WS_WD   = 1256 * MiB;
constexpr size_t WS_END  = 1512 * MiB;
constexpr int CW_BAR = 1024;

constexpr int RING_BYTES = 131072, MISC_OFF = RING_BYTES, GTAB_OFF = RING_BYTES + 1024, SCT_OFF = GTAB_OFF + 16384, LDS_BYTES = SCT_OFF + 3072;

__device__ __forceinline__ unsigned cvt_pk_bf16(float lo, float hi) { unsigned r; asm volatile("v_cvt_pk_bf16_f32 %0, %1, %2" : "=v"(r) : "v"(lo), "v"(hi)); return r; }
__device__ __forceinline__ float bf_lo(unsigned w) { return __builtin_bit_cast(float, w << 16); }
__device__ __forceinline__ float bf_hi(unsigned w) { return __builtin_bit_cast(float, w & 0xffff0000u); }
constexpr float W8_SCALE = 64.f, H8_SCALE = 8.f, YS8_SCALE = 64.f;
__device__ __forceinline__ unsigned pk4_fp8(float a, float b, float c, float d) { int w = __builtin_amdgcn_cvt_pk_fp8_f32(a, b, 0, false); w = __builtin_amdgcn_cvt_pk_fp8_f32(c, d, w, true); return (unsigned)w; }
__device__ __forceinline__ float shx(float v, int o, int lane) { return __builtin_bit_cast(float, __builtin_amdgcn_ds_bpermute((lane ^ o) << 2, __builtin_bit_cast(int, v))); }
__device__ __forceinline__ unsigned shxu(unsigned v, int o, int lane) { return (unsigned)__builtin_amdgcn_ds_bpermute((lane ^ o) << 2, (int)v); }
__device__ __forceinline__ float wave_sum(float v, int lane) {
#pragma unroll
    for (int o = 1; o < 64; o <<= 1) v += shx(v, o, lane);
    return v;
}
#define LDS_WAIT() asm volatile("s_waitcnt lgkmcnt(0)" ::: "memory")
#define VM_WAIT() asm volatile("s_waitcnt vmcnt(0)" ::: "memory")

#define XB_TMO      128
#define XB_XCNT(j)  (256  + 64 * (j))
#define XB_XSUB(j)  (1280 + 64 * (j))
#define XB_XGEN(j)  (2304 + 64 * (j))
#define XB_TOP      3328
#define XB_TOPGEN   3392
#define XCD_BAR_WORDS 3456
#define XB_SPIN_CAP (1u << 18)
__device__ __forceinline__ unsigned xb_ld(unsigned* p)              { return __hip_atomic_load(p, __ATOMIC_RELAXED, __HIP_MEMORY_SCOPE_AGENT); }
__device__ __forceinline__ unsigned xb_add(unsigned* p, unsigned v) { return __hip_atomic_fetch_add(p, v, __ATOMIC_RELAXED, __HIP_MEMORY_SCOPE_AGENT); }
__device__ __forceinline__ unsigned xb_xcc_id() { return (unsigned)__builtin_amdgcn_s_getreg((3 << 11) | 20) & 0xFu; }
#define XB_SPIN(cond, bar) do { unsigned _sp = 0; while (cond) { __builtin_amdgcn_s_sleep(1); \
    if ((++_sp & 255u) == 0u) { if (xb_ld(&(bar)[XB_TMO])) break; if (_sp > XB_SPIN_CAP) { atomicAdd(&(bar)[XB_TMO], 1u); break; } } } } while (0)
struct XcdBarrier { unsigned* bar; unsigned x; volatile LAS unsigned* st; };
__device__ __forceinline__ XcdBarrier xcd_barrier_post(unsigned* bar, volatile LAS unsigned* st) {
    XcdBarrier b; b.bar = bar; b.x = xb_xcc_id(); b.st = st;
    if (threadIdx.x == 0) st[2] = xb_add(&bar[XB_XCNT(b.x)], 1u);
    return b;
}
__device__ __forceinline__ void xcd_barrier_complete(unsigned* bar, unsigned x, unsigned& nloc, unsigned& nx) {
    const unsigned G = gridDim.x * gridDim.y * gridDim.z;
    unsigned sum, cnt, mine, sp = 0u;
    for (;;) {
        sum = 0u; cnt = 0u; mine = 0u;
#pragma unroll
        for (unsigned j = 0; j < 16; ++j) { const unsigned c = xb_ld(&bar[XB_XCNT(j)]); sum += c; cnt += (c > 0u) ? 1u : 0u; mine = (j == x) ? c : mine; }
        if (sum == G) break;
        __builtin_amdgcn_s_sleep(1);
        if ((++sp & 255u) == 0u) { if (xb_ld(&bar[XB_TMO])) break; if (sp > XB_SPIN_CAP) { atomicAdd(&bar[XB_TMO], 1u); break; } }
    }
    nloc = mine > 0u ? mine : 1u; nx = cnt > 0u ? cnt : 1u;
}
__device__ __forceinline__ void xcd_barrier(const XcdBarrier& b, const int wave_id) {
    asm volatile("s_waitcnt vmcnt(0)" ::: "memory");
    __syncthreads();
    int ln_; asm volatile("v_mbcnt_lo_u32_b32 %0, -1, 0\n\tv_mbcnt_hi_u32_b32 %0, -1, %0" : "=v"(ln_));
    if (wave_id == 0 && ln_ == 0) {
        unsigned* bar = b.bar; unsigned bx = b.x;
        asm volatile("" : "+s"(bar), "+s"(bx));
        __builtin_amdgcn_s_waitcnt(0);
        unsigned nloc = b.st[0], nx = b.st[1];
        if (nloc == 0u) { xcd_barrier_complete(bar, bx, nloc, nx); b.st[0] = nloc; b.st[1] = nx; }
        const unsigned old = xb_add(&bar[XB_XSUB(bx)], 1u);
        const unsigned gen = old / nloc;
        if (old + 1u == (gen + 1u) * nloc) {
            __builtin_amdgcn_fence(__ATOMIC_RELEASE, "agent");
            asm volatile("s_waitcnt vmcnt(0)" ::: "memory");
            const unsigned og = xb_add(&bar[XB_TOP], 1u);
            const unsigned tg = og / nx;
            if (og + 1u == (tg + 1u) * nx) xb_add(&bar[XB_TOPGEN], 1u);
            else XB_SPIN(xb_ld(&bar[XB_TOPGEN]) == tg, bar);
            __builtin_amdgcn_fence(__ATOMIC_ACQUIRE, "agent");
            xb_add(&bar[XB_XGEN(bx)], 1u);
            asm volatile("s_waitcnt vmcnt(0)" ::: "memory");
        } else {
            XB_SPIN(xb_ld(&bar[XB_XGEN(bx)]) == gen, bar);
            __builtin_amdgcn_fence(__ATOMIC_ACQUIRE, "agent");
            asm volatile("s_waitcnt vmcnt(0)" ::: "memory");
        }
    }
    __syncthreads();
}

__device__ __forceinline__ bool xcd_barrier_arrive(const XcdBarrier& b, const int wave_id, const unsigned nbar) {
    asm volatile("s_waitcnt vmcnt(0)" ::: "memory");
    __syncthreads();
    int ln_; asm volatile("v_mbcnt_lo_u32_b32 %0, -1, 0\n\tv_mbcnt_hi_u32_b32 %0, -1, %0" : "=v"(ln_));
    if (wave_id == 0 && ln_ == 0) {
        unsigned* bar = b.bar; unsigned bx = b.x;
        asm volatile("" : "+s"(bar), "+s"(bx));
        __builtin_amdgcn_s_waitcnt(0);
        unsigned nloc = b.st[0], nx = b.st[1];
        if (nloc == 0u) { xcd_barrier_complete(bar, bx, nloc, nx); b.st[0] = nloc; b.st[1] = nx; }
        (void)xb_add(&bar[XB_XSUB(bx)], 1u);
        b.st[3] = nbar;
    }
    __syncthreads();
    const unsigned nloc = (unsigned)__builtin_amdgcn_readfirstlane((int)b.st[0]), rank = (unsigned)__builtin_amdgcn_readfirstlane((int)b.st[2]);
    return rank != nbar % nloc;
}
__device__ __forceinline__ void xcd_barrier_finish(const XcdBarrier& b, const int wave_id, const unsigned nbar) {
    __syncthreads();
    int ln_; asm volatile("v_mbcnt_lo_u32_b32 %0, -1, 0\n\tv_mbcnt_hi_u32_b32 %0, -1, %0" : "=v"(ln_));
    if (wave_id == 0 && ln_ == 0) {
        unsigned* bar = b.bar; unsigned bx = b.x;
        asm volatile("" : "+s"(bar), "+s"(bx));
        const unsigned nloc = b.st[0], nx = b.st[1], gen = nbar;
        if (b.st[2] == gen % nloc) {
            XB_SPIN(xb_ld(&bar[XB_XSUB(bx)]) < (gen + 1u) * nloc, bar);
            __builtin_amdgcn_fence(__ATOMIC_RELEASE, "agent");
            asm volatile("s_waitcnt vmcnt(0)" ::: "memory");
            const unsigned og = xb_add(&bar[XB_TOP], 1u);
            const unsigned tg = og / nx;
            if (og + 1u == (tg + 1u) * nx) xb_add(&bar[XB_TOPGEN], 1u);
            else XB_SPIN(xb_ld(&bar[XB_TOPGEN]) == tg, bar);
            xb_add(&bar[XB_XGEN(bx)], 1u);
            __builtin_amdgcn_fence(__ATOMIC_ACQUIRE, "agent");
            asm volatile("s_waitcnt vmcnt(0)" ::: "memory");
        } else {
            XB_SPIN(xb_ld(&bar[XB_XGEN(bx)]) == gen, bar);
            __builtin_amdgcn_fence(__ATOMIC_ACQUIRE, "agent");
            asm volatile("s_waitcnt vmcnt(0)" ::: "memory");
        }
    }
    __syncthreads();
}

namespace pg8 {
constexpr int BM = 256, BK = 64, HALF = 128, HTB = HALF * BK * 2, STAGE_BYTES = 8 * HTB;
__device__ __forceinline__ int lds_byte(int r, int c) { const int st = (r >> 4) * 2 + (c >> 5), rr = r & 15, cc = c & 31, ob = rr * 64 + cc * 2; return st * 1024 + (ob ^ (((ob >> 9) & 1) << 5)); }
__device__ __forceinline__ void stage_rc(int b, int& R, int& C) { const int st = b / 1024, sb = b % 1024, swz = sb ^ (((sb >> 9) & 1) << 5); R = (st >> 1) * 16 + swz / 64; C = (st & 1) * 32 + (swz % 64) / 2; }
__device__ __forceinline__ int perm32(int rho) { const int n = rho >> 4, i = rho & 15; return 8 * (i >> 2) + 4 * n + (i & 3); }

typedef int i32x8 __attribute__((ext_vector_type(8)));
typedef double f64x2z __attribute__((ext_vector_type(2)));
typedef int i32x4 __attribute__((ext_vector_type(4)));
__device__ __forceinline__ i32x8 cat8(bf16x8 lo, bf16x8 hi) { const i32x4 a = __builtin_bit_cast(i32x4, lo), b = __builtin_bit_cast(i32x4, hi); return __builtin_shufflevector(a, b, 0, 1, 2, 3, 4, 5, 6, 7); }
struct Unit { const char* a; const char* b; int pm, pn; };

template <int NT  , int PITCH  , bool FP8  , bool GATHER, bool SCL  , class Epi, class Sched>
__device__ __forceinline__ void gemm_phase(LAS unsigned char* lds, const int wave_id, const Sched& S, const Epi& E, const unsigned* gro = nullptr) {
    int lane_; asm volatile("v_mbcnt_lo_u32_b32 %0, -1, 0\n\tv_mbcnt_hi_u32_b32 %0, -1, %0" : "=v"(lane_)); const int tid_ = wave_id * 64 + lane_;
    const int tid = tid_, wid = wave_id, lane = lane_, wr = wid >> 2, wc = wid & 3, fr = lane & 15, fq = lane >> 4;
    constexpr int nt = NT;
    static_assert(NT % 2 == 0 && NT >= 4, "K");
    unsigned voffA[2], voffB[2];
#pragma unroll
    for (int i = 0; i < 2; ++i) { int R, C; stage_rc(tid * 16 + i * 8192, R, C); const int Rb = (R & ~31) + perm32(R & 31);
        voffA[i] = GATHER ? (unsigned)(C * 2) : (unsigned)(R * PITCH + C * 2); voffB[i] = (unsigned)(Rb * PITCH + C * 2); }
    const unsigned gtab = (unsigned)(size_t)lds + (unsigned)STAGE_BYTES + 1024u;
    constexpr size_t kstep = (size_t)(BK * 2);
    constexpr size_t hstep = (size_t)HALF * PITCH;
    const unsigned ldsb = (unsigned)(size_t)lds + (unsigned)wid * 1024u;
    const int aoff = lds_byte(wr * 64 + fr, fq * 8), boff = lds_byte(wc * 32 + fr, fq * 8);
#define PG8_SA(b, h) (((b) * 2 + (h)) * HTB)
#define PG8_SB(b, h) ((4 + (b) * 2 + (h)) * HTB)
#define PG8_DMA16(voff_, sbase_, ldsdst_) do { unsigned _keep; asm volatile("s_mov_b32 %0, m0\n\ts_mov_b32 m0, %3\n\ts_nop 0\n\tglobal_load_lds_dwordx4 %1, %2\n\ts_mov_b32 m0, %0" : "=&s"(_keep) : "v"(voff_), "s"((const char*)(sbase_)), "s"(ldsdst_) : "memory"); } while (0)
#define PG8_STAGE(bufoff, gbase, voff) do { _Pragma("unroll") for (int _i = 0; _i < 2; ++_i) PG8_DMA16((voff)[_i], gbase, ldsb + (unsigned)((bufoff) + _i * 8192)); } while (0)
#define PG8_STAGE_A(bufoff, gbase_, h_, tb_) do { if constexpr (GATHER) { _Pragma("unroll") for (int _i = 0; _i < 2; ++_i) { \
            const unsigned _o = *(const LAS unsigned*)(size_t)(gtab + (unsigned)(tb_) * 8192u + (unsigned)(((h_) * 2 + _i) * 2048) + (unsigned)tid * 4u) + voffA[0]; \
            PG8_DMA16(_o, gbase_, ldsb + (unsigned)((bufoff) + _i * 8192)); } } \
        else { PG8_STAGE(bufoff, (gbase_) + (h_) * hstep, voffA); } } while (0)
#define PG8_GFILL(tb_, ro_) do { _Pragma("unroll") for (int _h = 0; _h < 2; ++_h) _Pragma("unroll") for (int _i = 0; _i < 2; ++_i) { unsigned _keep; \
        asm volatile("s_mov_b32 %0, m0\n\ts_mov_b32 m0, %3\n\ts_nop 0\n\tglobal_load_lds_dword %1, %2\n\ts_mov_b32 m0, %0" : "=&s"(_keep) : "v"((unsigned)(lane & ~3)), "s"((const char*)(ro_) + _h * 512 + 64 * ((wid + 8 * _i) >> 1)), \
                     "s"(gtab + (unsigned)(tb_) * 8192u + (unsigned)((_h * 2 + _i) * 2048) + (unsigned)wid * 256u) : "memory"); } } while (0)
#define PG8_SCFILL(buf_, ptr_) do { if (wid < 4) { unsigned _keep; const char* _p = (const char*)(ptr_) + wid * 256; \
        const unsigned _lo = (unsigned)__builtin_amdgcn_readfirstlane((int)(unsigned)(size_t)_p), _hi = (unsigned)__builtin_amdgcn_readfirstlane((int)(unsigned)((size_t)_p >> 32)); \
        const char* _ps = (const char*)(((size_t)_hi << 32) | (size_t)_lo); \
        asm volatile("s_mov_b32 %0, m0\n\ts_mov_b32 m0, %3\n\ts_nop 0\n\tglobal_load_lds_dword %1, %2\n\ts_mov_b32 m0, %0" : "=&s"(_keep) : "v"((unsigned)(lane * 4)), "s"(_ps), \
                     "s"((unsigned)(size_t)lds + (unsigned)(STAGE_BYTES + 1024 + 16384) + (unsigned)(buf_) * 1024u + (unsigned)wid * 256u) : "memory"); } } while (0)
#define PG8_LDA(dst, b, h) do { _Pragma("unroll") for (int m = 0; m < 4; ++m) _Pragma("unroll") for (int k = 0; k < 2; ++k) dst[m][k] = *(const LAS bf16x8*)(lds + PG8_SA(b, h) + aoff + m * 2048 + k * 1024); } while (0)
#define PG8_LDB(dst, b, h) do { _Pragma("unroll") for (int n = 0; n < 2; ++n) _Pragma("unroll") for (int k = 0; k < 2; ++k) dst[n][k] = *(const LAS bf16x8*)(lds + PG8_SB(b, h) + boff + n * 2048 + k * 1024); } while (0)
#define PG8_MMA(ai, bj, At, Bt) do { __builtin_amdgcn_s_setprio(1); _Pragma("unroll") for (int m = 0; m < 4; ++m) _Pragma("unroll") for (int n = 0; n < 2; ++n) { \
        if constexpr (FP8) acc[ai][bj][m][n] = __builtin_amdgcn_mfma_scale_f32_16x16x128_f8f6f4(cat8(Bt[n][0], Bt[n][1]), cat8(At[m][0], At[m][1]), acc[ai][bj][m][n], 0, 0, 0, 0, 0, 0);     \
        else { _Pragma("unroll") for (int k = 0; k < 2; ++k) acc[ai][bj][m][n] = __builtin_amdgcn_mfma_f32_16x16x32_bf16(Bt[n][k], At[m][k], acc[ai][bj][m][n], 0, 0, 0); } } __builtin_amdgcn_s_setprio(0); } while (0)
#define PG8_WAIT_V(n) asm volatile("s_waitcnt vmcnt(" #n ")" ::: "memory")
#define PG8_WAIT_L(n) asm volatile("s_waitcnt lgkmcnt(" #n ")" ::: "memory")
#define PG8_BAR __builtin_amdgcn_s_barrier()
#define PG8_SCHED __builtin_amdgcn_sched_barrier(0)
    Unit cur, nxt; int ui = 0;
    if (!S.next(0, cur)) return;
    LAS float* const sctab = (LAS float*)(lds + STAGE_BYTES + 1024 + 16384);
    int sb = 0;
    if constexpr (SCL) { PG8_SCFILL(0, E.scales(cur)); }
    f32x4 acc[2][2][4][2];
#pragma unroll
    for (int a = 0; a < 2; ++a)
#pragma unroll
        for (int b = 0; b < 2; ++b)
#pragma unroll
            for (int m = 0; m < 4; ++m)
#pragma unroll
                for (int n = 0; n < 2; ++n) { double z0_, z1_; asm volatile("v_mov_b64 %0, 0\n\tv_mov_b64 %1, 0" : "=v"(z0_), "=v"(z1_)); acc[a][b][m][n] = __builtin_bit_cast(f32x4, (f64x2z){z0_, z1_}); }
    bf16x8 At[4][2], B0[2][2], B1[2][2];
    const char* cA = cur.a; const char* cB = cur.b;
    if constexpr (GATHER) { const int pm0 = __builtin_amdgcn_readfirstlane(cur.pm); PG8_GFILL(0, gro + 256 * pm0); }
    PG8_STAGE(PG8_SB(0, 0), cB, voffB); PG8_STAGE(PG8_SB(0, 1), cB + hstep, voffB);
    if constexpr (GATHER) PG8_WAIT_V(4);
    PG8_STAGE_A(PG8_SA(0, 0), cA, 0, 0); PG8_STAGE_A(PG8_SA(0, 1), cA, 1, 0);
    if (wr == 1) PG8_BAR;
    PG8_WAIT_V(2); PG8_BAR;
    PG8_STAGE(PG8_SB(1, 0), cB + kstep, voffB); PG8_STAGE_A(PG8_SA(1, 0), cA + kstep, 0, 0); PG8_STAGE(PG8_SB(1, 1), cB + hstep + kstep, voffB);
    PG8_WAIT_V(6); PG8_BAR;
    for (;;) {
        const bool has_next = S.next(ui + 1, nxt);
        const int sbn = (sb == 2) ? 0 : sb + 1;
        if constexpr (SCL) { if (has_next) PG8_SCFILL(sbn, E.scales(nxt)); }
        const char* nA = has_next ? nxt.a : cA + (size_t)(nt - 2) * kstep; const char* nB = has_next ? nxt.b : cB + (size_t)(nt - 2) * kstep;
        const int tbc = ui & 1, tbn = has_next ? (tbc ^ 1) : tbc;
        if constexpr (GATHER) { if (has_next) PG8_GFILL(tbn, gro + 256 * nxt.pm); }
        for (int t = 0; t < nt; t += 2) {
            const bool last = (t == nt - 2);
            const char* a1 = cA + (size_t)(t + 1) * kstep;
            const char* a2 = last ? nA : cA + (size_t)(t + 2) * kstep; const char* b2 = last ? nB : cB + (size_t)(t + 2) * kstep;
            const char* a3 = a2 + kstep; const char* b3 = b2 + kstep;
            const int tb2 = last ? tbn : tbc;
            PG8_LDB(B0, 0, 0); PG8_LDB(B1, 0, 1); PG8_SCHED; PG8_LDA(At, 0, 0); PG8_STAGE_A(PG8_SA(1, 1), a1, 1, tbc);
            PG8_WAIT_V(8); PG8_WAIT_L(0); PG8_BAR; PG8_MMA(0, 0, At, B0); PG8_MMA(0, 1, At, B1); PG8_BAR; PG8_SCHED;
            PG8_LDA(At, 0, 1); PG8_STAGE(PG8_SB(0, 0), b2, voffB); PG8_STAGE(PG8_SB(0, 1), b2 + hstep, voffB); PG8_STAGE_A(PG8_SA(0, 0), a2, 0, tb2);
            PG8_WAIT_V(8); PG8_WAIT_L(0); PG8_BAR; PG8_MMA(1, 0, At, B0); PG8_MMA(1, 1, At, B1); PG8_BAR; PG8_SCHED;
            PG8_LDB(B0, 1, 0); PG8_LDB(B1, 1, 1); PG8_SCHED; PG8_LDA(At, 1, 0); PG8_STAGE_A(PG8_SA(0, 1), a2, 1, tb2);
            PG8_WAIT_V(8); PG8_WAIT_L(0); PG8_BAR; PG8_MMA(0, 0, At, B0); PG8_MMA(0, 1, At, B1); PG8_BAR; PG8_SCHED;
            PG8_LDA(At, 1, 1); PG8_STAGE(PG8_SB(1, 0), b3, voffB); PG8_STAGE(PG8_SB(1, 1), b3 + hstep, voffB); PG8_STAGE_A(PG8_SA(1, 0), a3, 0, tb2);
            PG8_WAIT_V(8); PG8_WAIT_L(0); PG8_BAR; PG8_MMA(1, 0, At, B0); PG8_MMA(1, 1, At, B1); PG8_BAR; PG8_SCHED;
        }
        if (wr == 0) PG8_BAR;
        { int le_; asm volatile("v_mbcnt_lo_u32_b32 %0, -1, 0\n\tv_mbcnt_hi_u32_b32 %0, -1, %0" : "=v"(le_)); E(acc, cur, wr, wc, le_ & 15, le_ >> 4, (const LAS float*)(sctab + sb * 256)); }
        if (!has_next) break;
#pragma unroll
        for (int a = 0; a < 2; ++a)
#pragma unroll
            for (int b = 0; b < 2; ++b)
#pragma unroll
                for (int m = 0; m < 4; ++m)
#pragma unroll
                    for (int n = 0; n < 2; ++n) { double z0_, z1_; asm volatile("v_mov_b64 %0, 0\n\tv_mov_b64 %1, 0" : "=v"(z0_), "=v"(z1_)); acc[a][b][m][n] = __builtin_bit_cast(f32x4, (f64x2z){z0_, z1_}); }
        cur = nxt; cA = nA; cB = nB; ++ui; sb = sbn;
        if (wr == 1) PG8_BAR;
    }
    PG8_WAIT_V(0);
    PG8_BAR;
#undef PG8_SA
#undef PG8_SB
#undef PG8_STAGE
#undef PG8_STAGE_A
#undef PG8_DMA16
#undef PG8_GFILL
#undef PG8_SCFILL
#undef PG8_LDA
#undef PG8_LDB
#undef PG8_MMA
#undef PG8_WAIT_V
#undef PG8_WAIT_L
#undef PG8_BAR
#undef PG8_SCHED
}

__device__ __forceinline__ void tile_of(int L, int n, int nN, int& pm, int& pn) {
    const int q = n >> 3, w = (L & 7) * q + (L >> 3);
    const int nig = 8 * nN, gid = w / nig, rem = w % nig;
    pm = gid * 8 + (rem & 7); pn = rem >> 3;
}

__device__ __forceinline__ f32x4 ld4s(const float* p) { return *(const f32x4*)p; }
__device__ __forceinline__ f32x4 ld4s(const LAS float* p) { return *(const LAS f32x4*)p; }
template <class T> struct IdT { typedef T type; };
template <bool ROWS, bool COLS, class SP = const float*>
__device__ __forceinline__ void store_tile_bf16(const f32x4 (&acc)[2][2][4][2], bf16* base, int ldc, typename IdT<SP>::type rowscale, typename IdT<SP>::type colscale, int wr, int wc, int fr, int fq, const float gscale = 1.f) {
    const int row0 = wr * 64 + fr, col0 = wc * 32 + 8 * fq;
    f32x4 cs[2][2];
#pragma unroll
    for (int bj = 0; bj < 2; ++bj)
#pragma unroll
        for (int n = 0; n < 2; ++n) cs[bj][n] = COLS ? ld4s(colscale + col0 + bj * HALF + 4 * n) : (f32x4){1.f, 1.f, 1.f, 1.f};
#pragma unroll
    for (int ai = 0; ai < 2; ++ai)
#pragma unroll
        for (int m = 0; m < 4; ++m) {
            const int r = row0 + ai * HALF + m * 16;
            const float rs = ROWS ? rowscale[r] * gscale : 1.f;
            bf16* rowp = base + (size_t)r * ldc + col0;
#pragma unroll
            for (int bj = 0; bj < 2; ++bj) {
                f32x4 v0 = acc[ai][bj][m][0], v1 = acc[ai][bj][m][1];
                if (COLS) { v0 = v0 * cs[bj][0]; v1 = v1 * cs[bj][1]; }
                if (ROWS) { v0 = v0 * rs; v1 = v1 * rs; }
                u32x4 w; w.x = cvt_pk_bf16(v0[0], v0[1]); w.y = cvt_pk_bf16(v0[2], v0[3]); w.z = cvt_pk_bf16(v1[0], v1[1]); w.w = cvt_pk_bf16(v1[2], v1[3]);
                *(u32x4*)(rowp + bj * HALF) = w; } }
}
}
using pg8::Unit;
typedef const f32x4 (&AccRef)[2][2][4][2];

struct Args { const float* in[13]; float* out; unsigned char* ws; int ph_lo, ph_hi; };
struct Frame {
    LAS unsigned char* lds; int tid, lane, wave, G, gw, NGW, bx;
    const float *x, *g1, *w_in, *w_f, *w_p, *p_s, *w_out, *g2, *w_r, *w_g, *w_u, *w_d, *gf;
    float* out; unsigned char* ws;
};

struct OrdFold {
    unsigned char* ws; int stage, G, c;
    __device__ __forceinline__ bool next(int i, Unit& u) const {
        const int L = i * G + c; if (L >= 128) return false;
        const int l = L >> 6, r = L & 63, mt = r & 7, q = r >> 3;
        u.pm = L; u.pn = 0;
        if (stage == 0) {
            const int g = q & 3;
            u.a = (const char*)((const bf16*)(ws + WS_WOT) + ((size_t)(l * 8 + q) * D + 256 * mt) * 256);
            u.b = (const char*)((const bf16*)(ws + (q < 4 ? WS_WF : WS_WPS)) + (size_t)(l * 4 + g) * 65536);
        } else {
            const int g = q >> 1, nt = q & 1;
            u.a = (const char*)((const bf16*)(ws + WS_TT) + ((size_t)(l * 4 + g) * D + 256 * mt) * 256);
            u.b = (const char*)((const bf16*)(ws + WS_CCS) + (size_t)nt * 65536);
        }
        return true;
    }
};
struct EpiFold {
    unsigned char* ws; int stage;
    __device__ __forceinline__ const float* scales(const Unit&) const { return nullptr; }
    __device__ __forceinline__ void operator()(AccRef acc, const Unit& u, int wr, int wc, int fr, int fq, const LAS float* sc) const {
        const int L = u.pm, l = L >> 6, r = L & 63, mt = r & 7, q = r >> 3;
        bf16* wo2 = (bf16*)(ws + WS_WO2) + ((size_t)(l * 2) * D + 256 * mt) * 2048;
        if (stage == 0) { const int g = q & 3;
            if (q < 4) pg8::store_tile_bf16<false, false>(acc, (bf16*)(ws + WS_TT) + ((size_t)(l * 4 + g) * D + 256 * mt) * 256, 256, nullptr, nullptr, wr, wc, fr, fq);
            else { pg8::store_tile_bf16<false, false>(acc, wo2 + 1024 + 256 * g, 2048, nullptr, nullptr, wr, wc, fr, fq);
                   pg8::store_tile_bf16<false, false>(acc, wo2 + (size_t)D * 2048 + 1024 + 256 * g, 2048, nullptr, nullptr, wr, wc, fr, fq); } }
        else { const int g = q >> 1, nt = q & 1; pg8::store_tile_bf16<false, false>(acc, wo2 + (size_t)nt * D * 2048 + 256 * g, 2048, nullptr, nullptr, wr, wc, fr, fq); }
    }
};
struct OrdWin {
    unsigned char* ws; int l, G, c, u0, u1;
    __device__ __forceinline__ bool next(int i, Unit& u) const {
        i += u0; if (i >= u1) return false;
        const int L = i * G + c; if (L >= 512) return false;
        pg8::tile_of(L, 512, 8, u.pm, u.pn);
        const char* xb = (const char*)((const bf16*)(ws + WS_XB) + (size_t)(256 * u.pm) * D);
        const char* w = (const char*)((const bf16*)(ws + WS_WIN) + (size_t)l * D * D + (size_t)(256 * u.pn) * D);
        if (u.pn < 4) { u.a = w; u.b = xb; } else { u.a = xb; u.b = w; }
        return true;
    }
};
struct EpiWin {
    unsigned char* ws;
    __device__ __forceinline__ const float* scales(const Unit& u) const { return (const float*)(ws + WS_RMS1) + 256 * u.pm; }
    __device__ __forceinline__ void operator()(AccRef acc, const Unit& u, int wr, int wc, int fr, int fq, const LAS float* sc) const {
        if (u.pn < 4) { const int b = u.pm >> 4, l0 = (u.pm & 15) * 256;
            pg8::store_tile_bf16<false, true, const LAS float*>(acc, (bf16*)(ws + WS_UT) + ((size_t)(b * 1024 + 256 * u.pn)) * SEQ + l0, SEQ, nullptr, sc, wr, wc, fr, fq); }
        else pg8::store_tile_bf16<true, false, const LAS float*>(acc, (bf16*)(ws + WS_UP) + (size_t)(256 * u.pm) * 1024 + 256 * (u.pn - 4), 1024, sc, nullptr, wr, wc, fr, fq);
    }
};
struct OrdDft {
    unsigned char* ws; int G, c, u0, u1;
    __device__ __forceinline__ bool next(int i, Unit& u) const {
        i += u0; if (i >= u1) return false;
        const int L = i * G + c; if (L >= 256) return false;
        u.pm = L >> 2; u.pn = L & 3;
        const int b = u.pm >> 4, k1 = u.pm & 15, ksrc = (k1 <= 8) ? k1 : 16 - k1;
        u.a = (const char*)(ws + WS_CS) + (size_t)k1 * (256 * 512 * 2);
        u.b = (const char*)(ws + WS_ZT) + ((size_t)(b * 9 + ksrc) * 1024 + 256 * u.pn) * 1024;
        return true;
    }
};
struct EpiDft {
    unsigned char* ws;
    __device__ __forceinline__ const float* scales(const Unit&) const { return nullptr; }
    __device__ __forceinline__ void operator()(AccRef acc, const Unit& u, int wr, int wc, int fr, int fq, const LAS float* sc) const {
        const int b = u.pm >> 4, k1 = u.pm & 15;
#pragma unroll
        for (int ai = 0; ai < 2; ++ai) {
            bf16* base = (bf16*)(ws + WS_F) + ((size_t)(ai * NB + b) * KH) * 2048 + 256 * u.pn + wc * 32 + 8 * fq;
#pragma unroll
            for (int m = 0; m < 4; ++m) {
                const int k = k1 + 16 * (wr * 64 + fr + m * 16);
#pragma unroll
                for (int bj = 0; bj < 2; ++bj) {
                    const f32x4 v0 = acc[ai][bj][m][0], v1 = acc[ai][bj][m][1];
                    u32x4 w; w.x = cvt_pk_bf16(v0[0], v0[1]); w.y = cvt_pk_bf16(v0[2], v0[3]); w.z = cvt_pk_bf16(v1[0], v1[1]); w.w = cvt_pk_bf16(v1[2], v1[3]);
                    *(u32x4*)(base + (size_t)k * 2048 + bj * 128) = w; } } }
    }
};
struct OrdWout {
    unsigned char* ws; int l, G, c, u0, u1;
    __device__ __forceinline__ bool next(int i, Unit& u) const {
        i += u0; if (i >= u1) return false;
        if (i >= 2 || c >= 256) return false;
        int pm, pn; pg8::tile_of(c, 256, 8, pm, pn);
        const int b = pm >> 3, kt = pm & 7;
        u.a = (const char*)((const bf16*)(ws + WS_F) + ((size_t)(i * NB + b) * KH + 256 * kt) * 2048);
        u.b = (const char*)((const bf16*)(ws + WS_WO2) + ((size_t)(l * 2 + i) * D + 256 * pn) * 2048);
        u.pm = pm | (i << 8); u.pn = pn;
        return true;
    }
};
struct EpiSD {
    unsigned char* ws; int bx;
    __device__ __forceinline__ const float* scales(const Unit&) const { return nullptr; }
    __device__ __forceinline__ void operator()(AccRef acc, const Unit& u, int wr, int wc, int fr, int fq, const LAS float* sc) const {
        bf16* ss = (bf16*)(ws + WS_SS) + (size_t)bx * 65536;
        if ((u.pm >> 8) == 0) { pg8::store_tile_bf16<false, false>(acc, ss, 256, nullptr, nullptr, wr, wc, fr, fq); return; }
        const int pm = u.pm & 255, b = pm >> 3, kt = pm & 7;
        const int row0 = wr * 64 + fr, col0 = wc * 32 + 8 * fq;
        bf16* xbb = (bf16*)(ws + WS_XB) + (size_t)(b * SEQ) * D + 256 * u.pn + col0; unsigned char* x8b = ws + WS_XS + (size_t)(b * SEQ) * D + 256 * u.pn + col0;
        u32x4 sw[2][2], r0[2][2], r1[2][2];
#define SD_LOAD(bf_, it_) do { const int r_ = row0 + ((it_) >> 2) * 128 + ((it_) & 3) * 16, k_ = 256 * kt + r_, km_ = (k_ == 0) ? 0 : SEQ - k_; \
            _Pragma("unroll") for (int bj = 0; bj < 2; ++bj) { sw[bf_][bj] = *(const u32x4*)(ss + (size_t)r_ * 256 + col0 + bj * 128); \
                r0[bf_][bj] = *(const u32x4*)(xbb + (size_t)k_ * D + bj * 128); r1[bf_][bj] = *(const u32x4*)(xbb + (size_t)km_ * D + bj * 128); } } while (0)
        SD_LOAD(0, 0);
#pragma unroll
        for (int it = 0; it < 8; ++it) {
            const int ai = it >> 2, m = it & 3, bf = it & 1;
            const int r = row0 + ai * 128 + m * 16, k = 256 * kt + r, km = (k == 0) ? 0 : SEQ - k;
            if (it + 1 < 8) SD_LOAD(bf ^ 1, it + 1);
#pragma unroll
            for (int bj = 0; bj < 2; ++bj) {
                const u32x4 swv = sw[bf][bj];
                const f32x4 s0 = (f32x4){bf_lo(swv.x), bf_hi(swv.x), bf_lo(swv.y), bf_hi(swv.y)}, s1 = (f32x4){bf_lo(swv.z), bf_hi(swv.z), bf_lo(swv.w), bf_hi(swv.w)};
                const f32x4 d0 = acc[ai][bj][m][0], d1 = acc[ai][bj][m][1];
                { const u32x4 rr = r0[bf][bj];
                  const f32x4 v0 = (s0 + d0) + (f32x4){bf_lo(rr.x), bf_hi(rr.x), bf_lo(rr.y), bf_hi(rr.y)}, v1 = (s1 + d1) + (f32x4){bf_lo(rr.z), bf_hi(rr.z), bf_lo(rr.w), bf_hi(rr.w)};
                  u32x4 w; w.x = cvt_pk_bf16(v0[0], v0[1]); w.y = cvt_pk_bf16(v0[2], v0[3]); w.z = cvt_pk_bf16(v1[0], v1[1]); w.w = cvt_pk_bf16(v1[2], v1[3]);
                  *(u32x4*)(xbb + (size_t)k * D + bj * 128) = w;
                  u32x2 q; q.x = pk4_fp8(v0[0], v0[1], v0[2], v0[3]); q.y = pk4_fp8(v1[0], v1[1], v1[2], v1[3]); *(u32x2*)(x8b + (size_t)k * D + bj * 128) = q; }
                if (k != 0) { const u32x4 rr = r1[bf][bj];
                  const f32x4 v0 = (s0 - d0) + (f32x4){bf_lo(rr.x), bf_hi(rr.x), bf_lo(rr.y), bf_hi(rr.y)}, v1 = (s1 - d1) + (f32x4){bf_lo(rr.z), bf_hi(rr.z), bf_lo(rr.w), bf_hi(rr.w)};
                  u32x4 w; w.x = cvt_pk_bf16(v0[0], v0[1]); w.y = cvt_pk_bf16(v0[2], v0[3]); w.z = cvt_pk_bf16(v1[0], v1[1]); w.w = cvt_pk_bf16(v1[2], v1[3]);
                  *(u32x4*)(xbb + (size_t)km * D + bj * 128) = w;
                  u32x2 q; q.x = pk4_fp8(v0[0], v0[1], v0[2], v0[3]); q.y = pk4_fp8(v1[0], v1[1], v1[2], v1[3]); *(u32x2*)(x8b + (size_t)km * D + bj * 128) = q; }
            }
            asm volatile("" ::: "memory");
        }
#undef SD_LOAD
    }
};
struct OrdFfn1 {
    unsigned char* ws; int l, G, c, u0, u1;
    __device__ __forceinline__ bool next(int i, Unit& u) const {
        i += u0; if (i >= u1) return false;
        const int L = i * G + c; if (L >= 2048) return false;
        pg8::tile_of(L, 2048, 16, u.pm, u.pn);
        u.a = (const char*)(ws + WS_XS);
        u.b = (const char*)(ws + WS_WGU) + ((size_t)(l * NE + (u.pm >> 3)) * 4096 + 256 * u.pn) * D;
        return true;
    }
};
struct EpiSwiglu {
    unsigned char* ws;
    __device__ __forceinline__ const float* scales(const Unit& u) const { return (const float*)(ws + WS_SRS) + 256 * u.pm; }
    __device__ __forceinline__ void operator()(AccRef acc, const Unit& u, int wr, int wc, int fr, int fq, const LAS float* sc) const {
        unsigned char* base = ws + WS_HID + (size_t)(256 * u.pm) * D + 128 * u.pn;
        const int row0 = wr * 64 + fr, col0 = wc * 32 + 8 * fq;
#pragma unroll
        for (int ai = 0; ai < 2; ++ai)
#pragma unroll
            for (int m = 0; m < 4; ++m) {
                const int r = row0 + ai * 128 + m * 16;
                const float rs = sc[r] * (1.0f / W8_SCALE), kt = rs * -1.44269504089f, ik2 = __builtin_amdgcn_rcpf(rs * rs * H8_SCALE);
                float h[8];
#pragma unroll
                for (int n = 0; n < 2; ++n)
#pragma unroll
                    for (int j = 0; j < 4; j += 2) {
                        const f32x2 ag = (f32x2){acc[ai][0][m][n][j], acc[ai][0][m][n][j + 1]}, au = (f32x2){acc[ai][1][m][n][j], acc[ai][1][m][n][j + 1]};
                        const f32x2 t = ag * kt;
                        f32x2 d; d.x = __builtin_amdgcn_exp2f(t.x); d.y = __builtin_amdgcn_exp2f(t.y);
                        d = d * ik2 + ik2;
                        f32x2 rc; rc.x = __builtin_amdgcn_rcpf(d.x); rc.y = __builtin_amdgcn_rcpf(d.y);
                        const f32x2 hv = (ag * au) * rc;
                        h[n * 4 + j] = __builtin_amdgcn_fmed3f(hv.x, -448.f, 448.f); h[n * 4 + j + 1] = __builtin_amdgcn_fmed3f(hv.y, -448.f, 448.f);
                    }
                u32x2 w; w.x = pk4_fp8(h[0], h[1], h[2], h[3]); w.y = pk4_fp8(h[4], h[5], h[6], h[7]);
                *(u32x2*)(base + (size_t)r * D + col0) = w; }
    }
};
struct OrdFfn2 {
    unsigned char* ws; int l, G, c, u0, u1;
    __device__ __forceinline__ bool next(int i, Unit& u) const {
        i += u0; if (i >= u1) return false;
        const int L = i * G + c; if (L >= 1024) return false;
        pg8::tile_of(L, 1024, 8, u.pm, u.pn);
        u.a = (const char*)(ws + WS_HID) + (size_t)(256 * u.pm) * D;
        u.b = (const char*)(ws + WS_WD) + ((size_t)(l * NE + (u.pm >> 3)) * D + 256 * u.pn) * D;
        return true;
    }
};
struct EpiDown {
    unsigned char* ws;
    __device__ __forceinline__ const float* scales(const Unit& u) const { return (const float*)(ws + WS_SGT) + 256 * u.pm; }
    __device__ __forceinline__ void operator()(AccRef acc, const Unit& u, int wr, int wc, int fr, int fq, const LAS float* sc) const {
        unsigned char* base = ws + WS_YS + (size_t)(256 * u.pm) * D + 256 * u.pn;
        const int row0 = wr * 64 + fr, col0 = wc * 32 + 8 * fq;
#pragma unroll
        for (int ai = 0; ai < 2; ++ai)
#pragma unroll
            for (int m = 0; m < 4; ++m) {
                const int r = row0 + ai * 128 + m * 16;
                const float scl = sc[r] * (YS8_SCALE / (W8_SCALE * H8_SCALE));
#pragma unroll
                for (int bj = 0; bj < 2; ++bj) { f32x4 v0 = acc[ai][bj][m][0] * scl, v1 = acc[ai][bj][m][1] * scl;
#pragma unroll
                    for (int j = 0; j < 4; ++j) { v0[j] = __builtin_amdgcn_fmed3f(v0[j], -448.f, 448.f); v1[j] = __builtin_amdgcn_fmed3f(v1[j], -448.f, 448.f); }
                    u32x2 q; q.x = pk4_fp8(v0[0], v0[1], v0[2], v0[3]); q.y = pk4_fp8(v1[0], v1[1], v1[2], v1[3]);
                    *(u32x2*)(base + (size_t)r * D + col0 + bj * 128) = q; } }
    }
};

__device__ __forceinline__ void tr_tile(const float* W, int ldw, const float* ks, bf16* dst, int dld, int k0, int n0, int drow0, int kd0, int lane) {
    const int kr = lane >> 4, nq = lane & 15;
    const float* src = W + (size_t)(k0 + 16 * kr) * ldw + n0 + 4 * nq;
    f32x4 v[16];
#pragma unroll
    for (int i = 0; i < 16; ++i) v[i] = __builtin_nontemporal_load((const f32x4*)(src + (size_t)i * ldw));
    if (ks) {
        const f32x4* kp = (const f32x4*)(ks + k0 + 16 * kr);
#pragma unroll
        for (int i4 = 0; i4 < 4; ++i4) { const f32x4 s = kp[i4];
#pragma unroll
            for (int j = 0; j < 4; ++j) v[i4 * 4 + j] = v[i4 * 4 + j] * s[j]; }
    }
#pragma unroll
    for (int j = 0; j < 4; ++j) {
        bf16* o = dst + (size_t)(drow0 + 4 * nq + j) * dld + kd0 + 16 * kr;
        u32x4 w0, w1;
        w0.x = cvt_pk_bf16(v[0][j], v[1][j]); w0.y = cvt_pk_bf16(v[2][j], v[3][j]); w0.z = cvt_pk_bf16(v[4][j], v[5][j]); w0.w = cvt_pk_bf16(v[6][j], v[7][j]);
        w1.x = cvt_pk_bf16(v[8][j], v[9][j]); w1.y = cvt_pk_bf16(v[10][j], v[11][j]); w1.z = cvt_pk_bf16(v[12][j], v[13][j]); w1.w = cvt_pk_bf16(v[14][j], v[15][j]);
        *(u32x4*)o = w0; *(u32x4*)(o + 8) = w1;
    }
}
struct Tr8 { const float* wg; const float* wu; const float* wd; const float* g2; unsigned char* ws; LAS unsigned char* lds; int wave, lane; };
__device__ __forceinline__ void tr8_load(const Tr8& T, int lw, int it, f32x4 (&v)[16]) {
    const int mid = it >> 7, r = it & 127, n0 = (r & 7) * 256, k0 = (r >> 3) * 128, le = lw * 16 + (mid & 15), kind = mid >> 4;
    const float* src = (kind == 0 ? T.wg : kind == 1 ? T.wu : T.wd) + (size_t)le * D * D + (size_t)(k0 + 16 * T.wave) * D + n0 + 4 * T.lane;
#pragma unroll
    for (int i = 0; i < 16; ++i) v[i] = __builtin_nontemporal_load((const f32x4*)(src + (size_t)i * D));
}
__device__ __forceinline__ void tr8_proc(const Tr8& T, int lw, int it, f32x4 (&v)[16], int p) {
    constexpr int PITCH = 144, IMG = 256 * PITCH;
    const int mid = it >> 7, r = it & 127, n0 = (r & 7) * 256, k0 = (r >> 3) * 128, le = lw * 16 + (mid & 15), kind = mid >> 4;
    if (kind < 2) { const float* ks = T.g2 + (le >> 4) * D + k0 + 16 * T.wave;
#pragma unroll
        for (int i = 0; i < 16; ++i) v[i] = v[i] * (ks[i] * W8_SCALE); }
    else {
#pragma unroll
        for (int i = 0; i < 16; ++i) v[i] = v[i] * W8_SCALE; }
    LAS unsigned char* img = T.lds + p * IMG;
#pragma unroll
    for (int j = 0; j < 4; ++j) { u32x4 w;
        w.x = pk4_fp8(v[0][j], v[1][j], v[2][j], v[3][j]); w.y = pk4_fp8(v[4][j], v[5][j], v[6][j], v[7][j]);
        w.z = pk4_fp8(v[8][j], v[9][j], v[10][j], v[11][j]); w.w = pk4_fp8(v[12][j], v[13][j], v[14][j], v[15][j]);
        *(LAS u32x4*)(img + (4 * T.lane + j) * PITCH + 16 * T.wave) = w; }
    asm volatile("s_waitcnt lgkmcnt(0)" ::: "memory"); __builtin_amdgcn_s_barrier(); asm volatile("" ::: "memory");
    unsigned char* dst = (kind < 2) ? T.ws + WS_WGU + (size_t)le * 4096 * D : T.ws + WS_WD + (size_t)le * D * D;
#pragma unroll
    for (int q = 0; q < 4; ++q) {
        const int row = 32 * T.wave + 8 * q + (T.lane >> 3), ch = T.lane & 7, n = n0 + row;
        const int drow = (kind < 2) ? ((n >> 7) * 256 + (n & 127) + (kind == 1 ? 128 : 0)) : n;
        const u32x4 w = *(const LAS u32x4*)(img + row * PITCH + 16 * ch);
        __builtin_nontemporal_store(w, (u32x4*)(dst + (size_t)drow * D + k0 + 16 * ch)); }
}
__device__ __forceinline__ void p_conv(Frame& F, int j0, int j1) {
    const Tr8 T{F.w_g, F.w_u, F.w_d, F.g2, F.ws, F.lds, F.wave, F.lane};
    f32x4 va[16], vb[16];
    int j = j0, p = 0;
#define CV_LW(j_) ((j_) >= 24 ? 1 : 0)
#define CV_IT(j_) (((j_) - 24 * CV_LW(j_)) * F.G + F.bx)
    if (j < j1) tr8_load(T, CV_LW(j), CV_IT(j), va);
    while (j < j1) {
        const int j2 = j + 1; if (j2 < j1) tr8_load(T, CV_LW(j2), CV_IT(j2), vb);
        tr8_proc(T, CV_LW(j), CV_IT(j), va, p); p ^= 1;
        if (j2 >= j1) break;
        const int j3 = j2 + 1; if (j3 < j1) tr8_load(T, CV_LW(j3), CV_IT(j3), va);
        tr8_proc(T, CV_LW(j2), CV_IT(j2), vb, p); p ^= 1;
        j = j3;
    }
    __syncthreads();
#undef CV_LW
#undef CV_IT
}
__device__ __forceinline__ void add8_fp8(f32x4 (&v)[2], u32x2 w, float sc) {
    const f32x2 a = __builtin_amdgcn_cvt_pk_f32_fp8((int)w.x, false), b = __builtin_amdgcn_cvt_pk_f32_fp8((int)w.x, true), c = __builtin_amdgcn_cvt_pk_f32_fp8((int)w.y, false), d = __builtin_amdgcn_cvt_pk_f32_fp8((int)w.y, true);
    v[0] = v[0] + (f32x4){a.x, a.y, b.x, b.y} * sc; v[1] = v[1] + (f32x4){c.x, c.y, d.x, d.y} * sc;
}
__device__ __forceinline__ void row_pass(Frame& F, int row, bool from_x, bool final_out) {
    const int lane = F.lane;
    f32x4 v[4][2];
    if (from_x) { const float* sp = F.x + (size_t)row * D + 8 * lane;
#pragma unroll
        for (int j = 0; j < 4; ++j) { v[j][0] = *(const f32x4*)(sp + 512 * j); v[j][1] = *(const f32x4*)(sp + 512 * j + 4); } }
    else {
        const int* sel = (const int*)(F.ws + WS_SEL) + (size_t)row * NE;
        const int sv = (lane < NE) ? sel[lane] : -1;
        const bf16* bp = (const bf16*)(F.ws + WS_XB) + (size_t)row * D + 8 * lane;
#pragma unroll
        for (int j = 0; j < 4; ++j) { const u32x4 w = *(const u32x4*)(bp + 512 * j);
            v[j][0] = (f32x4){bf_lo(w.x), bf_hi(w.x), bf_lo(w.y), bf_hi(w.y)}; v[j][1] = (f32x4){bf_lo(w.z), bf_hi(w.z), bf_lo(w.w), bf_hi(w.w)}; }
        unsigned long long m = __ballot(sv >= 0);
        const int b = row >> 12;
        const unsigned char* ybase = F.ws + WS_YS + (size_t)(b * CAP) * D + 8 * lane;
        while (m) {
            const int e0 = __builtin_ctzll(m); m &= m - 1;
            const bool two = (m != 0ull);
            const int e1 = two ? __builtin_ctzll(m) : e0; if (two) m &= m - 1;
            const int s0 = __builtin_amdgcn_readlane(sv, e0), s1 = __builtin_amdgcn_readlane(sv, e1);
            const unsigned char* y0 = ybase + ((size_t)e0 * ESL + s0) * D; const unsigned char* y1 = ybase + ((size_t)e1 * ESL + s1) * D;
            u32x2 w0[4], w1[4];
#pragma unroll
            for (int j = 0; j < 4; ++j) { w0[j] = *(const u32x2*)(y0 + 512 * j); w1[j] = *(const u32x2*)(y1 + 512 * j); }
#pragma unroll
            for (int j = 0; j < 4; ++j) add8_fp8(v[j], w0[j], 1.0f / YS8_SCALE);
            if (two) {
#pragma unroll
                for (int j = 0; j < 4; ++j) add8_fp8(v[j], w1[j], 1.0f / YS8_SCALE); }
        }
    }
    float ss = 0.f;
#pragma unroll
    for (int j = 0; j < 4; ++j)
#pragma unroll
        for (int h = 0; h < 2; ++h) ss += (v[j][h][0] * v[j][h][0] + v[j][h][1] * v[j][h][1]) + (v[j][h][2] * v[j][h][2] + v[j][h][3] * v[j][h][3]);
    const float inv = 1.f / sqrtf(wave_sum(ss, lane) * (1.f / D) + RMS_EPS);
    if (final_out) {
        float* op = F.out + (size_t)row * D + 8 * lane; const float* gp = F.gf + 8 * lane;
        f32x4 gq[4][2];
#pragma unroll
        for (int j = 0; j < 4; ++j) { gq[j][0] = *(const f32x4*)(gp + 512 * j); gq[j][1] = *(const f32x4*)(gp + 512 * j + 4); }
#pragma unroll
        for (int j = 0; j < 4; ++j)
#pragma unroll
            for (int h = 0; h < 2; ++h) *(f32x4*)(op + 512 * j + 4 * h) = v[j][h] * inv * gq[j][h];
    } else {
        bf16* bp = (bf16*)(F.ws + WS_XB) + (size_t)row * D + 8 * lane;
#pragma unroll
        for (int j = 0; j < 4; ++j) { u32x4 w; w.x = cvt_pk_bf16(v[j][0][0], v[j][0][1]); w.y = cvt_pk_bf16(v[j][0][2], v[j][0][3]); w.z = cvt_pk_bf16(v[j][1][0], v[j][1][1]); w.w = cvt_pk_bf16(v[j][1][2], v[j][1][3]);
            *(u32x4*)(bp + 512 * j) = w; }
        if (lane == 0) ((float*)(F.ws + WS_RMS1))[row] = inv;
    }
}
__device__ __forceinline__ bf16 f2bf(float v) { return (bf16)(cvt_pk_bf16(v, 0.f) & 0xffffu); }
__device__ __forceinline__ void p_prep(Frame& F) {
    LAS float* ctab = (LAS float*)F.lds;
    for (int i = F.tid; i < 4096; i += 512) ctab[i] = cospif((float)i * (1.0f / 2048.0f));
    __syncthreads();
    const int gt = F.bx * 512 + F.tid, NGT = F.G * 512;
    for (int i = gt; i < 512 * 256; i += NGT) {
        const int j = i >> 8, m = i & 255, ph = ((j & 255) * m) & 255;
        const float v = (j < 256) ? ctab[ph * 16] : -ctab[(ph * 16 + 3072) & 4095];
        ((bf16*)(F.ws + WS_CCS))[i] = f2bf(v * (1.0f / 1024.0f));
    }
    for (int i = gt; i < 16 * 256 * 512; i += NGT) {
        const int k1 = i >> 17, r = (i >> 9) & 255, kk = i & 511, p = r >> 7, k2 = r & 127, ri = kk >> 8, l2 = kk & 255, ph = ((k1 + 16 * k2) * l2) & 4095;
        const float c = ctab[ph], sn = ctab[(ph + 3072) & 4095], sg = (k1 <= 8) ? 1.f : -1.f;
        ((bf16*)(F.ws + WS_CS))[i] = f2bf(p == 0 ? (ri == 0 ? c : -sg * sn) : (ri == 0 ? sn : sg * c));
    }
    for (int i = gt; i < NL * 4 * 65536; i += NGT) {
        ((bf16*)(F.ws + WS_WF))[i] = f2bf(F.w_f[i]);
        const int lg = i >> 16, d = i & 255;
        ((bf16*)(F.ws + WS_WPS))[i] = f2bf(F.w_p[i] * F.p_s[lg * 256 + d]);
    }
    for (int i = gt; i < NL * NE * D; i += NGT) {
        const int l = i / (NE * D), e = (i / D) % NE, k = i % D;
        ((bf16*)(F.ws + WS_WR))[i] = f2bf(F.g2[l * D + k] * F.w_r[((size_t)l * D + k) * NE + e]);
    }
    for (int r = F.gw; r < T; r += F.NGW) row_pass(F, r, true, false);
    for (int it = F.gw; it < 4 * 1024; it += F.NGW) {
        const int mid = it >> 10, tile = it & 1023, k0 = (tile >> 5) * 64, n0 = (tile & 31) * 64;
        if (mid < 2) tr_tile(F.w_in + (size_t)mid * D * D, D, F.g1 + mid * D, (bf16*)(F.ws + WS_WIN) + (size_t)mid * D * D, D, k0, n0, n0, k0, F.lane);
        else tr_tile(F.w_out + (size_t)(mid - 2) * D * D, D, nullptr, (bf16*)(F.ws + WS_WOT) + ((size_t)(mid - 2) * 8 + (k0 >> 8)) * D * 256, 256, k0, n0, n0, k0 & 255, F.lane);
    }
}

__device__ __forceinline__ void ld8(const bf16* p, float (&o)[8]) { const u32x4 w = *(const u32x4*)p; o[0] = bf_lo(w.x); o[1] = bf_hi(w.x); o[2] = bf_lo(w.y); o[3] = bf_hi(w.y); o[4] = bf_lo(w.z); o[5] = bf_hi(w.z); o[6] = bf_lo(w.w); o[7] = bf_hi(w.w); }
template <int H, int MODE  >
__device__ __forceinline__ void pool_pass(const bf16* up, int r0, u32x4 (&pm)[8], bf16* fs, bf16* fd, float* ny, int t0) {
    u32x4 slot[8 + 2 * H];
#pragma unroll
    for (int s = 0; s < 8 + 2 * H; ++s) { const int row = r0 - H + s; slot[s] = (row >= 0 && row < SEQ) ? *(const u32x4*)(up + (size_t)row * 1024) : (u32x4){0u, 0u, 0u, 0u}; }
    float sum[8];
#pragma unroll
    for (int j = 0; j < 8; ++j) sum[j] = 0.f;
#pragma unroll
    for (int s = 0; s < 2 * H; ++s) { const u32x4 w = slot[s];
        sum[0] += bf_lo(w.x); sum[1] += bf_hi(w.x); sum[2] += bf_lo(w.y); sum[3] += bf_hi(w.y); sum[4] += bf_lo(w.z); sum[5] += bf_hi(w.z); sum[6] += bf_lo(w.w); sum[7] += bf_hi(w.w); }
#pragma unroll
    for (int i = 0; i < (MODE == 2 ? 1 : 8); ++i) {
        const int t = r0 + i;
        const int lo = (t - H) < 0 ? 0 : (t - H), hi = (t + H) > SEQ ? SEQ : (t + H);
        const float rc = (t < SEQ) ? 1.0f / (float)(hi - lo) : 0.f;
        u32x4 c = slot[i + H]; asm volatile("" : "+v"(c));
        const float cv[8] = {bf_lo(c.x), bf_hi(c.x), bf_lo(c.y), bf_hi(c.y), bf_lo(c.z), bf_hi(c.z), bf_lo(c.w), bf_hi(c.w)};
        float o8[8];
#pragma unroll
        for (int j = 0; j < 8; ++j) o8[j] = (t < SEQ) ? sum[j] * rc - cv[j] : 0.f;
        if constexpr (MODE == 0) {
            pm[i].x = cvt_pk_bf16(o8[0], o8[1]); pm[i].y = cvt_pk_bf16(o8[2], o8[3]); pm[i].z = cvt_pk_bf16(o8[4], o8[5]); pm[i].w = cvt_pk_bf16(o8[6], o8[7]);
        } else if constexpr (MODE == 1) {
            const bool first = (t0 + i == 0);
            const u32x4 mw = pm[7 - i];
            const float mv[8] = {bf_lo(mw.x), bf_hi(mw.x), bf_lo(mw.y), bf_hi(mw.y), bf_lo(mw.z), bf_hi(mw.z), bf_lo(mw.w), bf_hi(mw.w)};
            float ps[8], pd[8];
#pragma unroll
            for (int q = 0; q < 8; ++q) { const float a = o8[q], m = mv[q]; ps[q] = first ? a : 0.5f * (a + m); pd[q] = first ? 0.f : 0.5f * (a - m); }
            u32x4 w; w.x = cvt_pk_bf16(ps[0], ps[1]); w.y = cvt_pk_bf16(ps[2], ps[3]); w.z = cvt_pk_bf16(ps[4], ps[5]); w.w = cvt_pk_bf16(ps[6], ps[7]);
            *(u32x4*)(fs + (size_t)i * 2048) = w;
            w.x = cvt_pk_bf16(pd[0], pd[1]); w.y = cvt_pk_bf16(pd[2], pd[3]); w.z = cvt_pk_bf16(pd[4], pd[5]); w.w = cvt_pk_bf16(pd[6], pd[7]);
            *(u32x4*)(fd + (size_t)i * 2048) = w;
        } else { *(f32x4*)ny = (f32x4){o8[0], o8[1], o8[2], o8[3]}; *(f32x4*)(ny + 4) = (f32x4){o8[4], o8[5], o8[6], o8[7]}; }
        if (i < 7 && MODE != 2) { const u32x4 a = slot[i + 2 * H]; u32x4 d = slot[i]; asm volatile("" : "+v"(d));
            sum[0] += bf_lo(a.x) - bf_lo(d.x); sum[1] += bf_hi(a.x) - bf_hi(d.x); sum[2] += bf_lo(a.y) - bf_lo(d.y); sum[3] += bf_hi(a.y) - bf_hi(d.y);
            sum[4] += bf_lo(a.z) - bf_lo(d.z); sum[5] += bf_hi(a.z) - bf_hi(d.z); sum[6] += bf_lo(a.w) - bf_lo(d.w); sum[7] += bf_hi(a.w) - bf_hi(d.w); }
    }
}
template <int H>
__device__ __forceinline__ void pool_item(unsigned char* ws, int b, int c, int chunk) {
    const int t0 = chunk * 8;
    const bf16* up = (const bf16*)(ws + WS_UP) + (size_t)b * SEQ * 1024 + c;
    bf16* fs = (bf16*)(ws + WS_F) + ((size_t)b * KH + t0) * 2048 + 1024 + c; bf16* fd = fs + (size_t)NB * KH * 2048;
    float* ny = (float*)(ws + WS_NY) + (size_t)b * 2048 + 1024 + c;
    u32x4 pmr[8];
    pool_pass<H, 0>(up, SEQ - t0 - 7, pmr, fs, fd, ny, t0);
    asm volatile("" ::: "memory");
    pool_pass<H, 1>(up, t0, pmr, fs, fd, ny, t0);
    asm volatile("" ::: "memory");
    if (chunk == 255) pool_pass<H, 2>(up, 2048, pmr, fs, fd, ny, t0);
}
__device__ __forceinline__ void p_pool(Frame& F) {
    for (int it = F.wave * F.G + F.bx; it < 2048; it += F.NGW) {
        const int b = it >> 9, g = (it >> 7) & 3, chunk = 2 * (it & 127) + (F.lane >> 5), c = 256 * g + 8 * (F.lane & 31);
        switch (g) {
            case 0: pool_item<1>(F.ws, b, c, chunk); break;
            case 1: pool_item<2>(F.ws, b, c, chunk); break;
            case 2: pool_item<4>(F.ws, b, c, chunk); break;
            default: pool_item<8>(F.ws, b, c, chunk); break;
        }
    }
}

__device__ __forceinline__ void p_fft1(Frame& F) {
    constexpr float C16[16] = {1.f, 0.92387953251f, 0.70710678119f, 0.38268343236f, 0.f, -0.38268343236f, -0.70710678119f, -0.92387953251f, -1.f, -0.92387953251f, -0.70710678119f, -0.38268343236f, 0.f, 0.38268343236f, 0.70710678119f, 0.92387953251f};
    for (int it = F.bx * 512 + F.tid; it < NB * 1024 * 64; it += F.G * 512) {
        const int j4 = it & 63, bc = it >> 6, b = bc >> 10, c = bc & 1023, l2 = 4 * j4;
        const bf16* up = (const bf16*)(F.ws + WS_UT) + (size_t)bc * SEQ + l2;
        f32x4 x[16];
#pragma unroll
        for (int l1 = 0; l1 < 16; ++l1) { const u32x2 w = *(const u32x2*)(up + 256 * l1); x[l1] = (f32x4){bf_lo(w.x), bf_hi(w.x), bf_lo(w.y), bf_hi(w.y)}; }
        {
            float ny = 0.f;
#pragma unroll
            for (int l1 = 0; l1 < 16; ++l1) ny += (x[l1][0] - x[l1][1]) + (x[l1][2] - x[l1][3]);
            ny = wave_sum(ny, F.lane);
            if (F.lane == 0) ((float*)(F.ws + WS_NY))[(size_t)b * 2048 + c] = ny;
        }
        f32x4 t0[4], t1r[4], t1s[4], t2[4];
#pragma unroll
        for (int bp = 0; bp < 4; ++bp) { const f32x4 e = x[bp] + x[8 + bp], o = x[4 + bp] + x[12 + bp]; t0[bp] = e + o; t2[bp] = e - o; t1r[bp] = x[bp] - x[8 + bp]; t1s[bp] = x[4 + bp] - x[12 + bp]; }
        bf16* zp = (bf16*)(F.ws + WS_ZT) + (((size_t)(b * 9) * 1024 + c) * 2) * 256 + l2;
#pragma unroll
        for (int k1 = 0; k1 <= 8; ++k1) {
            const int q = k1 & 3;
            f32x4 yr = (f32x4){0.f, 0.f, 0.f, 0.f}, ys = yr;
#pragma unroll
            for (int bp = 0; bp < 4; ++bp) {
                const float ca = C16[(k1 * bp) & 15], sa = C16[((k1 * bp) + 12) & 15];
                const f32x4 tr = (q == 0) ? t0[bp] : (q == 2) ? t2[bp] : t1r[bp];
                if (q & 1) { const f32x4 ts = (q == 1) ? t1s[bp] : (f32x4){0.f, 0.f, 0.f, 0.f} - t1s[bp];
                    yr = yr + tr * ca - ts * sa; ys = ys + tr * sa + ts * ca; }
                else { yr = yr + tr * ca; ys = ys + tr * sa; }
            }
            u32x2 w0, w1;
            w0.x = cvt_pk_bf16(yr[0], yr[1]); w0.y = cvt_pk_bf16(yr[2], yr[3]); w1.x = cvt_pk_bf16(ys[0], ys[1]); w1.y = cvt_pk_bf16(ys[2], ys[3]);
            bf16* o = zp + (size_t)k1 * (1024 * 512);
            *(u32x2*)o = w0; *(u32x2*)(o + 256) = w1;
        }
    }
}

__device__ __forceinline__ void p_row2048(Frame& F, int l) {
    const int gwi = F.wave * F.G + F.bx;
    if (gwi >= NB * 512) return;
    const int b = gwi >> 9, n0 = (gwi & 511) * 4;
    const float* ny = (const float*)(F.ws + WS_NY) + (size_t)b * 2048 + 8 * F.lane;
    f32x4 a[4][2];
#pragma unroll
    for (int i = 0; i < 4; ++i) { a[i][0] = *(const f32x4*)(ny + 512 * i); a[i][1] = *(const f32x4*)(ny + 512 * i + 4); }
    const bf16* wrow = (const bf16*)(F.ws + WS_WO2) + ((size_t)(l * 2) * D + n0) * 2048 + 8 * F.lane;
    bf16* xb = (bf16*)(F.ws + WS_XB) + (size_t)(b * SEQ + 2048) * D + n0; unsigned char* x8 = F.ws + WS_XS + (size_t)(b * SEQ + 2048) * D + n0;
    const u32x2 xr = *(const u32x2*)xb;
    const float xres[4] = {bf_lo(xr.x), bf_hi(xr.x), bf_lo(xr.y), bf_hi(xr.y)};
    u32x4 wv[4][4];
#pragma unroll
    for (int j = 0; j < 4; ++j)
#pragma unroll
        for (int i = 0; i < 4; ++i) wv[j][i] = *(const u32x4*)(wrow + (size_t)j * 2048 + 512 * i);
    float dv[4];
#pragma unroll
    for (int j = 0; j < 4; ++j) {
        float d = 0.f;
#pragma unroll
        for (int i = 0; i < 4; ++i) { const u32x4 q = wv[j][i];
            d += (a[i][0][0] * bf_lo(q.x) + a[i][0][1] * bf_hi(q.x)) + (a[i][0][2] * bf_lo(q.y) + a[i][0][3] * bf_hi(q.y)) + (a[i][1][0] * bf_lo(q.z) + a[i][1][1] * bf_hi(q.z)) + (a[i][1][2] * bf_lo(q.w) + a[i][1][3] * bf_hi(q.w)); }
        dv[j] = wave_sum(d, F.lane);
    }
    if (F.lane == 0) {
#pragma unroll
        for (int j = 0; j < 4; ++j) { const float v = dv[j] + xres[j]; xb[j] = f2bf(v); x8[j] = (unsigned char)(pk4_fp8(v, 0.f, 0.f, 0.f) & 0xffu); }
    }
}

__device__ __forceinline__ void p_router(Frame& F, int l) {
    const int fr = F.lane & 15, fq = F.lane >> 4;
    for (int it = F.wave * F.G + F.bx; it < T / 16; it += F.NGW) {
        const int tok0 = it * 16;
        const bf16* xp = (const bf16*)(F.ws + WS_XB) + (size_t)(tok0 + fr) * D + 8 * fq;
        const bf16* wp = (const bf16*)(F.ws + WS_WR) + (size_t)l * NE * D + (size_t)fr * D + 8 * fq;
        f32x4 acc = (f32x4){0.f, 0.f, 0.f, 0.f}; float ss = 0.f;
#pragma unroll 16
        for (int ks = 0; ks < D / 32; ++ks) {
            const u32x4 xa = *(const u32x4*)(xp + 32 * ks); const u32x4 wb = *(const u32x4*)(wp + 32 * ks);
            ss += bf_lo(xa.x) * bf_lo(xa.x) + bf_hi(xa.x) * bf_hi(xa.x) + bf_lo(xa.y) * bf_lo(xa.y) + bf_hi(xa.y) * bf_hi(xa.y)
                + bf_lo(xa.z) * bf_lo(xa.z) + bf_hi(xa.z) * bf_hi(xa.z) + bf_lo(xa.w) * bf_lo(xa.w) + bf_hi(xa.w) * bf_hi(xa.w);
            acc = __builtin_amdgcn_mfma_f32_16x16x32_bf16(__builtin_bit_cast(bf16x8, wb), __builtin_bit_cast(bf16x8, xa), acc, 0, 0, 0);
        }
        ss += shx(ss, 16, F.lane); ss += shx(ss, 32, F.lane);
        const float inv = 1.f / sqrtf(ss * (1.f / D) + RMS_EPS);
        float z[4], mx;
#pragma unroll
        for (int j = 0; j < 4; ++j) z[j] = acc[j] * inv;
        mx = fmaxf(fmaxf(z[0], z[1]), fmaxf(z[2], z[3])); mx = fmaxf(mx, shx(mx, 16, F.lane)); mx = fmaxf(mx, shx(mx, 32, F.lane));
        float sm = 0.f;
#pragma unroll
        for (int j = 0; j < 4; ++j) { z[j] = __expf(z[j] - mx); sm += z[j]; }
        sm += shx(sm, 16, F.lane); sm += shx(sm, 32, F.lane);
        const float rsm = 1.f / sm;
        const int tok = tok0 + fr, b = tok >> 12, t = tok & 4095;
        float* pp = (float*)(F.ws + WS_PROB) + ((size_t)b * NE + 4 * fq) * SEQ + t;
#pragma unroll
        for (int j = 0; j < 4; ++j) pp[(size_t)j * SEQ] = z[j] * rsm;
        if (fq == 0) ((float*)(F.ws + WS_RMS2))[tok] = inv;
    }
}

__device__ __forceinline__ void p_topk(Frame& F, int l) {
    if (F.bx >= NB * NE) return;
    const int b = F.bx >> 4, e = F.bx & 15, tid = F.tid, lane = F.lane, wave = F.wave;
    LAS unsigned* red = (LAS unsigned*)F.lds;
    const float* pp = (const float*)(F.ws + WS_PROB) + ((size_t)b * NE + e) * SEQ + 8 * tid;
    unsigned key[8];
    float rv[8];
    { const float* r2p = (const float*)(F.ws + WS_RMS2) + (size_t)b * SEQ + 8 * tid; const f32x4 ra = *(const f32x4*)r2p, rb = *(const f32x4*)(r2p + 4);
      const u32x4 a = *(const u32x4*)pp, c = *(const u32x4*)(pp + 4); key[0] = a.x; key[1] = a.y; key[2] = a.z; key[3] = a.w; key[4] = c.x; key[5] = c.y; key[6] = c.z; key[7] = c.w;
      rv[0] = ra[0]; rv[1] = ra[1]; rv[2] = ra[2]; rv[3] = ra[3]; rv[4] = rb[0]; rv[5] = rb[1]; rv[6] = rb[2]; rv[7] = rb[3]; }
    unsigned thr = 0u;
    int itn = 0;
    for (int hi = 30; hi >= 0; hi -= 2, ++itn) {
        const bool pair = (hi >= 1);
        const unsigned bh = 1u << hi, bl = pair ? (1u << (hi - 1)) : 0u;
        const unsigned c10 = thr | bh, c11 = thr | bh | bl, c01 = thr | bl;
        unsigned n10 = 0, n11 = 0, n01 = 0;
#pragma unroll
        for (int j = 0; j < 8; ++j) { n10 += (unsigned)__popcll(__ballot(key[j] >= c10)); n11 += (unsigned)__popcll(__ballot(key[j] >= c11)); n01 += (unsigned)__popcll(__ballot(key[j] >= c01)); }
        LAS unsigned* slot = red + (itn & 1) * 24;
        if (lane == 0) { slot[wave] = n10; slot[8 + wave] = n11; slot[16 + wave] = n01; }
        __syncthreads();
        unsigned t10 = 0, t11 = 0, t01 = 0;
#pragma unroll
        for (int w = 0; w < 8; ++w) { t10 += slot[w]; t11 += slot[8 + w]; t01 += slot[16 + w]; }
        if (pair) thr = (t11 >= (unsigned)CAP) ? c11 : (t10 >= (unsigned)CAP) ? c10 : (t01 >= (unsigned)CAP) ? c01 : thr;
        else      thr = (t10 >= (unsigned)CAP) ? c10 : thr;
    }
    __syncthreads();
    unsigned cg = 0, ce = 0;
#pragma unroll
    for (int j = 0; j < 8; ++j) { cg += (key[j] > thr) ? 1u : 0u; ce += (key[j] == thr) ? 1u : 0u; }
    const unsigned pk = cg | (ce << 16); unsigned inc = pk;
#pragma unroll
    for (int o = 1; o < 64; o <<= 1) { const unsigned v = (unsigned)__builtin_amdgcn_ds_bpermute((lane - o) << 2, (int)inc); if (lane >= o) inc += v; }
    LAS unsigned* wtot = red + 64;
    if (lane == 63) wtot[wave] = inc;
    __syncthreads();
    unsigned base = 0, total = 0;
#pragma unroll
    for (int w = 0; w < 8; ++w) { const unsigned v = wtot[w]; if (w < wave) base += v; total += v; }
    const unsigned excl = base + inc - pk;
    unsigned pg = excl & 0xffffu, pe = excl >> 16;
    const unsigned ngt = total & 0xffffu, need_eq = (unsigned)CAP - ngt;
    unsigned* roff = (unsigned*)(F.ws + WS_ROFF) + ((size_t)l * NE + e) * ESL + b * CAP;
    float* srs = (float*)(F.ws + WS_SRS) + (size_t)e * ESL + b * CAP;
    float* sgt = (float*)(F.ws + WS_SGT) + (size_t)e * ESL + b * CAP;
    int* sel = (int*)(F.ws + WS_SEL) + ((size_t)b * SEQ + 8 * tid) * NE + e;
#pragma unroll
    for (int j = 0; j < 8; ++j) {
        int s = -1;
        if (key[j] > thr) { s = (int)pg; ++pg; }
        else if (key[j] == thr) { if (pe < need_eq) s = (int)(ngt + pe); ++pe; }
        sel[(size_t)j * NE] = s;
        if (s >= 0) { roff[s] = (unsigned)((b * SEQ + 8 * tid + j) * D); srs[s] = rv[j]; sgt[s] = __builtin_bit_cast(float, key[j]); }
    }
    __syncthreads();
}

struct RowIn { u32x4 xw[4]; u32x2 ya[4], yb[4]; int sv, e0, e1; unsigned long long rest; bool any, two; };
__device__ __forceinline__ int comb_sv(const Frame& F, int row) { const int* sel = (const int*)(F.ws + WS_SEL) + (size_t)row * NE; return (F.lane < NE) ? sel[F.lane] : -1; }
__device__ __forceinline__ void comb_load(const Frame& F, int row, int sv, RowIn& R) {
    R.sv = sv;
    const bf16* bp = (const bf16*)(F.ws + WS_XB) + (size_t)row * D + 8 * F.lane;
#pragma unroll
    for (int j = 0; j < 4; ++j) R.xw[j] = *(const u32x4*)(bp + 512 * j);
    unsigned long long m = __ballot(sv >= 0);
    R.any = (m != 0ull);
    const int e0 = R.any ? __builtin_ctzll(m) : 0; m &= m - 1;
    R.two = (m != 0ull);
    const int e1 = R.two ? __builtin_ctzll(m) : e0; if (R.two) m &= m - 1;
    R.e0 = e0; R.e1 = e1; R.rest = m;
    if (R.any) {
        const int b = row >> 12;
        const unsigned char* ybase = F.ws + WS_YS + (size_t)(b * CAP) * D + 8 * F.lane;
        const int s0 = __builtin_amdgcn_readlane(sv, e0), s1 = __builtin_amdgcn_readlane(sv, e1);
        const unsigned char* y0 = ybase + ((size_t)e0 * ESL + s0) * D; const unsigned char* y1 = ybase + ((size_t)e1 * ESL + s1) * D;
#pragma unroll
        for (int j = 0; j < 4; ++j) { R.ya[j] = *(const u32x2*)(y0 + 512 * j); R.yb[j] = *(const u32x2*)(y1 + 512 * j); }
    } else {
#pragma unroll
        for (int j = 0; j < 4; ++j) { R.ya[j] = (u32x2){0u, 0u}; R.yb[j] = (u32x2){0u, 0u}; }
    }
}
__device__ __forceinline__ void comb_proc(Frame& F, int row, const RowIn& R, bool final_out) {
    const int lane = F.lane;
    f32x4 v[4][2];
#pragma unroll
    for (int j = 0; j < 4; ++j) { const u32x4 w = R.xw[j];
        v[j][0] = (f32x4){bf_lo(w.x), bf_hi(w.x), bf_lo(w.y), bf_hi(w.y)}; v[j][1] = (f32x4){bf_lo(w.z), bf_hi(w.z), bf_lo(w.w), bf_hi(w.w)}; }
    if (R.any) {
#pragma unroll
        for (int j = 0; j < 4; ++j) add8_fp8(v[j], R.ya[j], 1.0f / YS8_SCALE);
        if (R.two) {
#pragma unroll
            for (int j = 0; j < 4; ++j) add8_fp8(v[j], R.yb[j], 1.0f / YS8_SCALE); }
    }
    const int sv = R.sv;
    unsigned long long m = R.rest;
    const int b = row >> 12;
    const unsigned char* ybase = F.ws + WS_YS + (size_t)(b * CAP) * D + 8 * lane;
    while (m) {
        const int e0 = __builtin_ctzll(m); m &= m - 1;
        const bool two = (m != 0ull);
        const int e1 = two ? __builtin_ctzll(m) : e0; if (two) m &= m - 1;
        const int s0 = __builtin_amdgcn_readlane(sv, e0), s1 = __builtin_amdgcn_readlane(sv, e1);
        const unsigned char* y0 = ybase + ((size_t)e0 * ESL + s0) * D; const unsigned char* y1 = ybase + ((size_t)e1 * ESL + s1) * D;
        u32x2 w0[4], w1[4];
#pragma unroll
        for (int j = 0; j < 4; ++j) { w0[j] = *(const u32x2*)(y0 + 512 * j); w1[j] = *(const u32x2*)(y1 + 512 * j); }
#pragma unroll
        for (int j = 0; j < 4; ++j) add8_fp8(v[j], w0[j], 1.0f / YS8_SCALE);
        if (two) {
#pragma unroll
            for (int j = 0; j < 4; ++j) add8_fp8(v[j], w1[j], 1.0f / YS8_SCALE); }
    }
    float ss = 0.f;
#pragma unroll
    for (int j = 0; j < 4; ++j)
#pragma unroll
        for (int h = 0; h < 2; ++h) ss += (v[j][h][0] * v[j][h][0] + v[j][h][1] * v[j][h][1]) + (v[j][h][2] * v[j][h][2] + v[j][h][3] * v[j][h][3]);
    const float inv = 1.f / sqrtf(wave_sum(ss, lane) * (1.f / D) + RMS_EPS);
    if (final_out) {
        float* op = F.out + (size_t)row * D + 8 * lane; const float* gp = F.gf + 8 * lane;
        f32x4 gq[4][2];
#pragma unroll
        for (int j = 0; j < 4; ++j) { gq[j][0] = *(const f32x4*)(gp + 512 * j); gq[j][1] = *(const f32x4*)(gp + 512 * j + 4); }
#pragma unroll
        for (int j = 0; j < 4; ++j)
#pragma unroll
            for (int h = 0; h < 2; ++h) *(f32x4*)(op + 512 * j + 4 * h) = v[j][h] * inv * gq[j][h];
    } else {
        bf16* bp = (bf16*)(F.ws + WS_XB) + (size_t)row * D + 8 * lane;
#pragma unroll
        for (int j = 0; j < 4; ++j) { u32x4 w; w.x = cvt_pk_bf16(v[j][0][0], v[j][0][1]); w.y = cvt_pk_bf16(v[j][0][2], v[j][0][3]); w.z = cvt_pk_bf16(v[j][1][0], v[j][1][1]); w.w = cvt_pk_bf16(v[j][1][2], v[j][1][3]);
            *(u32x4*)(bp + 512 * j) = w; }
        if (lane == 0) ((float*)(F.ws + WS_RMS1))[row] = inv;
    }
}
__device__ __forceinline__ void p_combine(Frame& F, bool final_out) {
    RowIn A, B;
    int r = F.wave * F.G + F.bx;
    int svA = (r < T) ? comb_sv(F, r) : -1;
    int svB = (r + F.NGW < T) ? comb_sv(F, r + F.NGW) : -1;
    if (r < T) comb_load(F, r, svA, A);
    while (r < T) {
        const int r2 = r + F.NGW, r3 = r2 + F.NGW, r4 = r3 + F.NGW;
        svA = (r3 < T) ? comb_sv(F, r3) : -1;
        if (r2 < T) comb_load(F, r2, svB, B);
        comb_proc(F, r, A, final_out);
        if (r2 >= T) break;
        svB = (r4 < T) ? comb_sv(F, r4) : -1;
        if (r3 < T) comb_load(F, r3, svA, A);
        comb_proc(F, r2, B, final_out);
        r = r3;
    }
}

constexpr int PPL = 8, N_PHASES = 1 + PPL * NL;
__global__ void __launch_bounds__(512, 2) fwd(Args args) {
    extern __shared__ __attribute__((aligned(16))) unsigned char lds_raw[];
    Frame F;
    F.lds = (LAS unsigned char*)lds_raw;
    F.tid = 0; F.lane = 0; F.wave = __builtin_amdgcn_readfirstlane(threadIdx.x >> 6);
    F.G = gridDim.x; F.gw = blockIdx.x * 8 + F.wave; F.NGW = F.G * 8;
    F.x = args.in[0]; F.g1 = args.in[1]; F.w_in = args.in[2]; F.w_f = args.in[3]; F.w_p = args.in[4]; F.p_s = args.in[5]; F.w_out = args.in[6];
    F.g2 = args.in[7]; F.w_r = args.in[8]; F.w_g = args.in[9]; F.w_u = args.in[10]; F.w_d = args.in[11]; F.gf = args.in[12];
    F.out = args.out; F.ws = args.ws;
    volatile LAS unsigned* misc = (volatile LAS unsigned*)(F.lds + MISC_OFF);
    if (threadIdx.x < 64) misc[threadIdx.x] = 0u;
    __syncthreads();
    unsigned* barw = (unsigned*)(F.ws + WS_CTL) + CW_BAR;
    XcdBarrier bar; bar.bar = barw; bar.x = 0; bar.st = nullptr;
    if (!MK_PER_PHASE) bar = xcd_barrier_post(barw, misc + 8);
    const int lo = args.ph_lo, hi = args.ph_hi;
#if MK_PER_PHASE
#define IN(k) (lo <= (k) && (k) < hi)
#else
#define IN(k) true
#endif
#define SEAM(k, mn_) do { if (IN(k) && IN((k) + 1)) { int wv_ = F.wave; asm volatile("" : "+s"(wv_)); const bool mem_ = xcd_barrier_arrive(bar, wv_, (unsigned)nbar); \
        if (SHADOW && mem_ && cvn >= (mn_) && cvn < 48) { LAUNDER; p_conv(Fp, cvn, cvn + 1); ++cvn; } \
        xcd_barrier_finish(bar, wv_, (unsigned)nbar); ++nbar; } } while (0)
    LAS unsigned char* ring = F.lds;
    F.bx = (int)blockIdx.x;

#define RLOOP(bit) _Pragma("nounroll") for (int rep_ = 0; rep_ < ((REP & (bit)) ? 2 : 1); ++rep_)
#define LAUNDER Frame Fp = F; { unsigned long long z_ = 0ull; asm volatile("" : "+s"(z_)); Fp.ws = F.ws + z_; }     asm volatile("" : "+s"(Fp.wave)); asm volatile("" : "+s"(Fp.bx)); Fp.gw = Fp.bx * 8 + Fp.wave; asm volatile("v_mbcnt_lo_u32_b32 %0, -1, 0\n\tv_mbcnt_hi_u32_b32 %0, -1, %0" : "=v"(Fp.lane)); Fp.tid = Fp.wave * 64 + Fp.lane
    RLOOP(1) if (IN(0)) { LAUNDER; p_prep(Fp); __syncthreads(); }
    int nbar = 0;
    int cvn = 0;
    SEAM(0, 0);
#define PHASEG(ng_, nu_, j0_, j1_, ...) { const int grp_ = (F.bx >> 3) % (ng_); const bool cv_ = cvn < (j1_); const int split_ = cv_ ? (grp_ * (nu_) * 2 + ((ng_) - 1)) / (2 * ((ng_) - 1)) : (nu_); \
    _Pragma("nounroll") for (int s_ = 0; s_ < 2; ++s_) { const int u0_ = s_ ? split_ : 0, u1_ = s_ ? (nu_) : split_; \
        if (u1_ > u0_) { __VA_ARGS__ } \
        if (s_ == 0 && cv_) { LAUNDER; p_conv(Fp, cvn, j1_); cvn = (j1_); } } }
#pragma nounroll
    for (int l = 0; l < NL; ++l) {
        const int pb = 1 + PPL * l;
        const int cW0 = l ? 28 : 0, cW1 = l ? 33 : 6, cO0 = l ? 33 : 6, cO1 = l ? 40 : 16, cF0 = l ? 40 : 16, cF1 = l ? 48 : 24, cG0 = 24, cG1 = l ? 24 : 28;
        if (l == 0) { LAUNDER; OrdFold S{Fp.ws, 0, F.G, Fp.bx}; EpiFold E{Fp.ws, 0}; pg8::gemm_phase<4, 512, false, false, false>(ring, Fp.wave, S, E); }
        PHASEG(3, 2, cW0, cW1, { LAUNDER; OrdWin S{Fp.ws, l, F.G, Fp.bx, u0_, u1_}; EpiWin E{Fp.ws}; pg8::gemm_phase<D / 64, D * 2, false, false, true>(ring, Fp.wave, S, E); })
        SEAM(pb + 0, l ? 24 : 0);
        if (l == 0) { LAUNDER; OrdFold S{Fp.ws, 1, F.G, Fp.bx}; EpiFold E{Fp.ws, 1}; pg8::gemm_phase<4, 512, false, false, false>(ring, Fp.wave, S, E); }
        { LAUNDER; p_fft1(Fp); p_pool(Fp); }
        SEAM(pb + 1, l ? 24 : 0);
        PHASEG(2, 1, 0, 0, { LAUNDER; OrdDft S{Fp.ws, F.G, Fp.bx, u0_, u1_}; EpiDft E{Fp.ws}; pg8::gemm_phase<8, 1024, false, false, false>(ring, Fp.wave, S, E); })
        SEAM(pb + 1, l ? 24 : 0);
        { LAUNDER; p_row2048(Fp, l); }
        PHASEG(3, 2, cO0, cO1, { LAUNDER; OrdWout S{Fp.ws, l, F.G, Fp.bx, u0_, u1_}; EpiSD E{Fp.ws, Fp.bx}; pg8::gemm_phase<KH / 64, KH * 2, false, false, false>(ring, Fp.wave, S, E); })
        SEAM(pb + 2, l ? 24 : 0);
        { LAUNDER; p_router(Fp, l); }
        SEAM(pb + 3, l ? 24 : 0);
        { LAUNDER; p_topk(Fp, l); }
        SEAM(pb + 4, l ? 40 : 16);
        PHASEG(8, 8, cF0, cF1, { LAUNDER; OrdFfn1 S{Fp.ws, l, F.G, Fp.bx, u0_, u1_}; EpiSwiglu E{Fp.ws}; pg8::gemm_phase<D / 128, D, true, true, true>(ring, Fp.wave, S, E, (const unsigned*)(Fp.ws + WS_ROFF) + (size_t)l * NE * ESL); })
        SEAM(pb + 5, l ? 48 : 24);
        PHASEG(5, 4, cG0, cG1, { LAUNDER; OrdFfn2 S{Fp.ws, l, F.G, Fp.bx, u0_, u1_}; EpiDown E{Fp.ws}; pg8::gemm_phase<D / 128, D, true, false, true>(ring, Fp.wave, S, E); })
        SEAM(pb + 6, l ? 48 : 24);
        { LAUNDER; p_combine(Fp, l == NL - 1); }
        if (l + 1 < NL) SEAM(pb + 7, 24);
    }
#undef PHASEG
#undef LAUNDER
#undef RLOOP
#undef IN
#undef SEAM
}

extern "C" void kernel_launch(void* const* d_in, const int* in_sizes, int n_in, void* d_out, int out_size, void* d_ws, size_t ws_size, hipStream_t stream) {
    static int grid = 0;
    if (grid == 0) {
        if (n_in != 13 || in_sizes[0] != T * D || out_size != T * D || ws_size < WS_END) {
            fprintf(stderr, "kernel_launch: unexpected shapes (n_in %d, in0 %d, out %d, ws %zu < %zu); nothing launched\n", n_in, n_in > 0 ? in_sizes[0] : -1, out_size, ws_size, (size_t)WS_END); grid = -1; return; }
        int dev = 0, cus = 0, per_cu = 0;
        if (hipGetDevice(&dev) != hipSuccess || hipDeviceGetAttribute(&cus, hipDeviceAttributeMultiprocessorCount, dev) != hipSuccess) { fprintf(stderr, "kernel_launch: device query failed\n"); grid = -1; return; }
        if (hipFuncSetAttribute((const void*)fwd, hipFuncAttributeMaxDynamicSharedMemorySize, LDS_BYTES) != hipSuccess) { fprintf(stderr, "kernel_launch: hipFuncSetAttribute failed\n"); grid = -1; return; }
        if (hipOccupancyMaxActiveBlocksPerMultiprocessor(&per_cu, (const void*)fwd, 512, LDS_BYTES) != hipSuccess || per_cu < 1) fprintf(stderr, "kernel_launch: occupancy query reports %d\n", per_cu);
        (void)hipGetLastError();
        grid = cus;
        if (grid > 256) grid = 256;
        grid &= ~7;
        if (grid != 256) fprintf(stderr, "kernel_launch: this kernel's unit maps assume 256 workgroups (one per CU of a 256-CU device); got %d\n", grid);
    }
    if (grid <= 0) return;
    (void)hipMemsetAsync((char*)d_ws + WS_CTL, 0, CTL_ZERO_BYTES, stream);
    Args a{};
    for (int i = 0; i < 13; ++i) a.in[i] = (const float*)d_in[i];
    a.out = (float*)d_out; a.ws = (unsigned char*)d_ws;
#if MK_PER_PHASE
    for (int p = 0; p < N_PHASES; ++p) { a.ph_lo = p; a.ph_hi = p + 1; hipLaunchKernelGGL(fwd, dim3(grid), dim3(512), LDS_BYTES, stream, a); }
#else
    a.ph_lo = 0; a.ph_hi = N_PHASES;
    hipLaunchKernelGGL(fwd, dim3(grid), dim3(512), LDS_BYTES, stream, a);
#endif
    const hipError_t le = hipPeekAtLastError();
    if (le != hipSuccess) fprintf(stderr, "kernel_launch: launch failed: %s\n", hipGetErrorName(le));
}
```

```cpp
#include <hip/hip_runtime.h>
#include <cstdio>
#include <cstdint>

#ifndef SHADOW
#define SHADOW 1
#endif
#ifndef REP
#define REP 0
#endif
#ifndef MK_PER_PHASE
#define MK_PER_PHASE 0
#endif

#define GAS __attribute__((address_space(1)))
#define LAS __attribute__((address_space(3)))
#define CAS __attribute__((address_space(4)))
typedef unsigned short bf16;
typedef short bf16x8 __attribute__((ext_vector_type(8)));
typedef float f32x4 __attribute__((ext_vector_type(4)));
typedef unsigned u32x4 __attribute__((ext_vector_type(4)));
typedef unsigned u32x2 __attribute__((ext_vector_type(2)));
typedef float f32x2 __attribute__((ext_vector_type(2)));

constexpr int NB = 4, SEQ = 4096, D = 2048, T = NB * SEQ, NL = 2, NE = 16, CAP = 512, ESL = NB * CAP  ;
constexpr int KH = 2048;
constexpr float RMS_EPS = 1e-6f;

constexpr size_t MiB = 1u << 20;
constexpr size_t WS_CTL = 0, CTL_ZERO_BYTES = 64 * 1024;
constexpr size_t WS_RMS1 = 1 * MiB;
constexpr size_t WS_RMS2 = WS_RMS1 + 64 * 1024;
constexpr size_t WS_WR   = WS_RMS2 + 64 * 1024;
constexpr size_t WS_CCS  = WS_WR + 128 * 1024;
constexpr size_t WS_SRS  = WS_CCS + 256 * 1024;
constexpr size_t WS_SGT  = WS_SRS + 128 * 1024;
constexpr size_t WS_ROFF = WS_SGT + 128 * 1024;
constexpr size_t WS_PROB = 2 * MiB;
constexpr size_t WS_SEL  = 3 * MiB;
constexpr size_t WS_WF   = 4 * MiB;
constexpr size_t WS_WPS  = 5 * MiB;
constexpr size_t WS_TT   = 6 * MiB;
constexpr size_t WS_WIN  = 16 * MiB;
constexpr size_t WS_WOT  = 32 * MiB;
constexpr size_t WS_WO2  = 48 * MiB;
constexpr size_t WS_NY   = 14 * MiB;
constexpr size_t WS_SS   = 264 * MiB;
constexpr size_t WS_CS   = 80 * MiB;
constexpr size_t WS_ZT   = 200 * MiB;
constexpr size_t WS_XB   = 136 * MiB;
constexpr size_t WS_UT   = 328 * MiB;
constexpr size_t WS_UP   = 360 * MiB;
constexpr size_t WS_F    = 392 * MiB;
constexpr size_t WS_HID  = 488 * MiB;
constexpr size_t WS_YS   = 616 * MiB;
constexpr size_t WS_XS   = 552 * MiB;
constexpr size_t WS_WGU  = 744 * MiB;
constexpr size_t WS_WD   = 1256 * MiB;
constexpr size_t WS_END  = 1512 * MiB;
constexpr int CW_BAR = 1024;

constexpr int RING_BYTES = 131072, MISC_OFF = RING_BYTES, GTAB_OFF = RING_BYTES + 1024, SCT_OFF = GTAB_OFF + 16384, LDS_BYTES = SCT_OFF + 3072;

__device__ __forceinline__ unsigned cvt_pk_bf16(float lo, float hi) { unsigned r; asm volatile("v_cvt_pk_bf16_f32 %0, %1, %2" : "=v"(r) : "v"(lo), "v"(hi)); return r; }
__device__ __forceinline__ float bf_lo(unsigned w) { return __builtin_bit_cast(float, w << 16); }
__device__ __forceinline__ float bf_hi(unsigned w) { return __builtin_bit_cast(float, w & 0xffff0000u); }
constexpr float W8_SCALE = 64.f, H8_SCALE = 8.f, YS8_SCALE = 64.f;
__device__ __forceinline__ unsigned pk4_fp8(float a, float b, float c, float d) { int w = __builtin_amdgcn_cvt_pk_fp8_f32(a, b, 0, false); w = __builtin_amdgcn_cvt_pk_fp8_f32(c, d, w, true); return (unsigned)w; }
__device__ __forceinline__ float shx(float v, int o, int lane) { return __builtin_bit_cast(float, __builtin_amdgcn_ds_bpermute((lane ^ o) << 2, __builtin_bit_cast(int, v))); }
__device__ __forceinline__ unsigned shxu(unsigned v, int o, int lane) { return (unsigned)__builtin_amdgcn_ds_bpermute((lane ^ o) << 2, (int)v); }
__device__ __forceinline__ float wave_sum(float v, int lane) {
#pragma unroll
    for (int o = 1; o < 64; o <<= 1) v += shx(v, o, lane);
    return v;
}
#define LDS_WAIT() asm volatile("s_waitcnt lgkmcnt(0)" ::: "memory")
#define VM_WAIT() asm volatile("s_waitcnt vmcnt(0)" ::: "memory")

#define XB_TMO      128
#define XB_XCNT(j)  (256  + 64 * (j))
#define XB_XSUB(j)  (1280 + 64 * (j))
#define XB_XGEN(j)  (2304 + 64 * (j))
#define XB_TOP      3328
#define XB_TOPGEN   3392
#define XCD_BAR_WORDS 3456
#define XB_SPIN_CAP (1u << 18)
__device__ __forceinline__ unsigned xb_ld(unsigned* p)              { return __hip_atomic_load(p, __ATOMIC_RELAXED, __HIP_MEMORY_SCOPE_AGENT); }
__device__ __forceinline__ unsigned xb_add(unsigned* p, unsigned v) { return __hip_atomic_fetch_add(p, v, __ATOMIC_RELAXED, __HIP_MEMORY_SCOPE_AGENT); }
__device__ __forceinline__ unsigned xb_xcc_id() { return (unsigned)__builtin_amdgcn_s_getreg((3 << 11) | 20) & 0xFu; }
#define XB_SPIN(cond, bar) do { unsigned _sp = 0; while (cond) { __builtin_amdgcn_s_sleep(1); \
    if ((++_sp & 255u) == 0u) { if (xb_ld(&(bar)[XB_TMO])) break; if (_sp > XB_SPIN_CAP) { atomicAdd(&(bar)[XB_TMO], 1u); break; } } } } while (0)
struct XcdBarrier { unsigned* bar; unsigned x; volatile LAS unsigned* st; };
__device__ __forceinline__ XcdBarrier xcd_barrier_post(unsigned* bar, volatile LAS unsigned* st) {
    XcdBarrier b; b.bar = bar; b.x = xb_xcc_id(); b.st = st;
    if (threadIdx.x == 0) st[2] = xb_add(&bar[XB_XCNT(b.x)], 1u);
    return b;
}
__device__ __forceinline__ void xcd_barrier_complete(unsigned* bar, unsigned x, unsigned& nloc, unsigned& nx) {
    const unsigned G = gridDim.x * gridDim.y * gridDim.z;
    unsigned sum, cnt, mine, sp = 0u;
    for (;;) {
        sum = 0u; cnt = 0u; mine = 0u;
#pragma unroll
        for (unsigned j = 0; j < 16; ++j) { const unsigned c = xb_ld(&bar[XB_XCNT(j)]); sum += c; cnt += (c > 0u) ? 1u : 0u; mine = (j == x) ? c : mine; }
        if (sum == G) break;
        __builtin_amdgcn_s_sleep(1);
        if ((++sp & 255u) == 0u) { if (xb_ld(&bar[XB_TMO])) break; if (sp > XB_SPIN_CAP) { atomicAdd(&bar[XB_TMO], 1u); break; } }
    }
    nloc = mine > 0u ? mine : 1u; nx = cnt > 0u ? cnt : 1u;
}
__device__ __forceinline__ void xcd_barrier(const XcdBarrier& b, const int wave_id) {
    asm volatile("s_waitcnt vmcnt(0)" ::: "memory");
    __syncthreads();
    int ln_; asm volatile("v_mbcnt_lo_u32_b32 %0, -1, 0\n\tv_mbcnt_hi_u32_b32 %0, -1, %0" : "=v"(ln_));
    if (wave_id == 0 && ln_ == 0) {
        unsigned* bar = b.bar; unsigned bx = b.x;
        asm volatile("" : "+s"(bar), "+s"(bx));
        __builtin_amdgcn_s_waitcnt(0);
        unsigned nloc = b.st[0], nx = b.st[1];
        if (nloc == 0u) { xcd_barrier_complete(bar, bx, nloc, nx); b.st[0] = nloc; b.st[1] = nx; }
        const unsigned old = xb_add(&bar[XB_XSUB(bx)], 1u);
        const unsigned gen = old / nloc;
        if (old + 1u == (gen + 1u) * nloc) {
            __builtin_amdgcn_fence(__ATOMIC_RELEASE, "agent");
            asm volatile("s_waitcnt vmcnt(0)" ::: "memory");
            const unsigned og = xb_add(&bar[XB_TOP], 1u);
            const unsigned tg = og / nx;
            if (og + 1u == (tg + 1u) * nx) xb_add(&bar[XB_TOPGEN], 1u);
            else XB_SPIN(xb_ld(&bar[XB_TOPGEN]) == tg, bar);
            __builtin_amdgcn_fence(__ATOMIC_ACQUIRE, "agent");
            xb_add(&bar[XB_XGEN(bx)], 1u);
            asm volatile("s_waitcnt vmcnt(0)" ::: "memory");
        } else {
            XB_SPIN(xb_ld(&bar[XB_XGEN(bx)]) == gen, bar);
            __builtin_amdgcn_fence(__ATOMIC_ACQUIRE, "agent");
            asm volatile("s_waitcnt vmcnt(0)" ::: "memory");
        }
    }
    __syncthreads();
}

__device__ __forceinline__ bool xcd_barrier_arrive(const XcdBarrier& b, const int wave_id, const unsigned nbar) {
    asm volatile("s_waitcnt vmcnt(0)" ::: "memory");
    __syncthreads();
    int ln_; asm volatile("v_mbcnt_lo_u32_b32 %0, -1, 0\n\tv_mbcnt_hi_u32_b32 %0, -1, %0" : "=v"(ln_));
    if (wave_id == 0 && ln_ == 0) {
        unsigned* bar = b.bar; unsigned bx = b.x;
        asm volatile("" : "+s"(bar), "+s"(bx));
        __builtin_amdgcn_s_waitcnt(0);
        unsigned nloc = b.st[0], nx = b.st[1];
        if (nloc == 0u) { xcd_barrier_complete(bar, bx, nloc, nx); b.st[0] = nloc; b.st[1] = nx; }
        (void)xb_add(&bar[XB_XSUB(bx)], 1u);
        b.st[3] = nbar;
    }
    __syncthreads();
    const unsigned nloc = (unsigned)__builtin_amdgcn_readfirstlane((int)b.st[0]), rank = (unsigned)__builtin_amdgcn_readfirstlane((int)b.st[2]);
    return rank != nbar % nloc;
}
__device__ __forceinline__ void xcd_barrier_finish(const XcdBarrier& b, const int wave_id, const unsigned nbar) {
    __syncthreads();
    int ln_; asm volatile("v_mbcnt_lo_u32_b32 %0, -1, 0\n\tv_mbcnt_hi_u32_b32 %0, -1, %0" : "=v"(ln_));
    if (wave_id == 0 && ln_ == 0) {
        unsigned* bar = b.bar; unsigned bx = b.x;
        asm volatile("" : "+s"(bar), "+s"(bx));
        const unsigned nloc = b.st[0], nx = b.st[1], gen = nbar;
        if (b.st[2] == gen % nloc) {
            XB_SPIN(xb_ld(&bar[XB_XSUB(bx)]) < (gen + 1u) * nloc, bar);
            __builtin_amdgcn_fence(__ATOMIC_RELEASE, "agent");
            asm volatile("s_waitcnt vmcnt(0)" ::: "memory");
            const unsigned og = xb_add(&bar[XB_TOP], 1u);
            const unsigned tg = og / nx;
            if (og + 1u == (tg + 1u) * nx) xb_add(&bar[XB_TOPGEN], 1u);
            else XB_SPIN(xb_ld(&bar[XB_TOPGEN]) == tg, bar);
            __builtin_amdgcn_fence(__ATOMIC_ACQUIRE, "agent");
            xb_add(&bar[XB_XGEN(bx)], 1u);
            asm volatile("s_waitcnt vmcnt(0)" ::: "memory");
        } else {
            XB_SPIN(xb_ld(&bar[XB_XGEN(bx)]) == gen, bar);
            __builtin_amdgcn_fence(__ATOMIC_ACQUIRE, "agent");
            asm volatile("s_waitcnt vmcnt(0)" ::: "memory");
        }
    }
    __syncthreads();
}

namespace pg8 {
constexpr int BM = 256, BK = 64, HALF = 128, HTB = HALF * BK * 2, STAGE_BYTES = 8 * HTB;
__device__ __forceinline__ int lds_byte(int r, int c) { const int st = (r >> 4) * 2 + (c >> 5), rr = r & 15, cc = c & 31, ob = rr * 64 + cc * 2; return st * 1024 + (ob ^ (((ob >> 9) & 1) << 5)); }
__device__ __forceinline__ void stage_rc(int b, int& R, int& C) { const int st = b / 1024, sb = b % 1024, swz = sb ^ (((sb >> 9) & 1) << 5); R = (st >> 1) * 16 + swz / 64; C = (st & 1) * 32 + (swz % 64) / 2; }
__device__ __forceinline__ int perm32(int rho) { const int n = rho >> 4, i = rho & 15; return 8 * (i >> 2) + 4 * n + (i & 3); }

typedef int i32x8 __attribute__((ext_vector_type(8)));
typedef double f64x2z __attribute__((ext_vector_type(2)));
typedef int i32x4 __attribute__((ext_vector_type(4)));
__device__ __forceinline__ i32x8 cat8(bf16x8 lo, bf16x8 hi) { const i32x4 a = __builtin_bit_cast(i32x4, lo), b = __builtin_bit_cast(i32x4, hi); return __builtin_shufflevector(a, b, 0, 1, 2, 3, 4, 5, 6, 7); }
struct Unit { const char* a; const char* b; int pm, pn; };

template <int NT  , int PITCH  , bool FP8  , bool GATHER, bool SCL  , class Epi, class Sched>
__device__ __forceinline__ void gemm_phase(LAS unsigned char* lds, const int wave_id, const Sched& S, const Epi& E, const unsigned* gro = nullptr) {
    int lane_; asm volatile("v_mbcnt_lo_u32_b32 %0, -1, 0\n\tv_mbcnt_hi_u32_b32 %0, -1, %0" : "=v"(lane_)); const int tid_ = wave_id * 64 + lane_;
    const int tid = tid_, wid = wave_id, lane = lane_, wr = wid >> 2, wc = wid & 3, fr = lane & 15, fq = lane >> 4;
    constexpr int nt = NT;
    static_assert(NT % 2 == 0 && NT >= 4, "K");
    unsigned voffA[2], voffB[2];
#pragma unroll
    for (int i = 0; i < 2; ++i) { int R, C; stage_rc(tid * 16 + i * 8192, R, C); const int Rb = (R & ~31) + perm32(R & 31);
        voffA[i] = GATHER ? (unsigned)(C * 2) : (unsigned)(R * PITCH + C * 2); voffB[i] = (unsigned)(Rb * PITCH + C * 2); }
    const unsigned gtab = (unsigned)(size_t)lds + (unsigned)STAGE_BYTES + 1024u;
    constexpr size_t kstep = (size_t)(BK * 2);
    constexpr size_t hstep = (size_t)HALF * PITCH;
    const unsigned ldsb = (unsigned)(size_t)lds + (unsigned)wid * 1024u;
    const int aoff = lds_byte(wr * 64 + fr, fq * 8), boff = lds_byte(wc * 32 + fr, fq * 8);
#define PG8_SA(b, h) (((b) * 2 + (h)) * HTB)
#define PG8_SB(b, h) ((4 + (b) * 2 + (h)) * HTB)
#define PG8_DMA16(voff_, sbase_, ldsdst_) do { unsigned _keep; asm volatile("s_mov_b32 %0, m0\n\ts_mov_b32 m0, %3\n\ts_nop 0\n\tglobal_load_lds_dwordx4 %1, %2\n\ts_mov_b32 m0, %0" : "=&s"(_keep) : "v"(voff_), "s"((const char*)(sbase_)), "s"(ldsdst_) : "memory"); } while (0)
#define PG8_STAGE(bufoff, gbase, voff) do { _Pragma("unroll") for (int _i = 0; _i < 2; ++_i) PG8_DMA16((voff)[_i], gbase, ldsb + (unsigned)((bufoff) + _i * 8192)); } while (0)
#define PG8_STAGE_A(bufoff, gbase_, h_, tb_) do { if constexpr (GATHER) { _Pragma("unroll") for (int _i = 0; _i < 2; ++_i) { \
            const unsigned _o = *(const LAS unsigned*)(size_t)(gtab + (unsigned)(tb_) * 8192u + (unsigned)(((h_) * 2 + _i) * 2048) + (unsigned)tid * 4u) + voffA[0]; \
            PG8_DMA16(_o, gbase_, ldsb + (unsigned)((bufoff) + _i * 8192)); } } \
        else { PG8_STAGE(bufoff, (gbase_) + (h_) * hstep, voffA); } } while (0)
#define PG8_GFILL(tb_, ro_) do { _Pragma("unroll") for (int _h = 0; _h < 2; ++_h) _Pragma("unroll") for (int _i = 0; _i < 2; ++_i) { unsigned _keep; \
        asm volatile("s_mov_b32 %0, m0\n\ts_mov_b32 m0, %3\n\ts_nop 0\n\tglobal_load_lds_dword %1, %2\n\ts_mov_b32 m0, %0" : "=&s"(_keep) : "v"((unsigned)(lane & ~3)), "s"((const char*)(ro_) + _h * 512 + 64 * ((wid + 8 * _i) >> 1)), \
                     "s"(gtab + (unsigned)(tb_) * 8192u + (unsigned)((_h * 2 + _i) * 2048) + (unsigned)wid * 256u) : "memory"); } } while (0)
#define PG8_SCFILL(buf_, ptr_) do { if (wid < 4) { unsigned _keep; const char* _p = (const char*)(ptr_) + wid * 256; \
        const unsigned _lo = (unsigned)__builtin_amdgcn_readfirstlane((int)(unsigned)(size_t)_p), _hi = (unsigned)__builtin_amdgcn_readfirstlane((int)(unsigned)((size_t)_p >> 32)); \
        const char* _ps = (const char*)(((size_t)_hi << 32) | (size_t)_lo); \
        asm volatile("s_mov_b32 %0, m0\n\ts_mov_b32 m0, %3\n\ts_nop 0\n\tglobal_load_lds_dword %1, %2\n\ts_mov_b32 m0, %0" : "=&s"(_keep) : "v"((unsigned)(lane * 4)), "s"(_ps), \
                     "s"((unsigned)(size_t)lds + (unsigned)(STAGE_BYTES + 1024 + 16384) + (unsigned)(buf_) * 1024u + (unsigned)wid * 256u) : "memory"); } } while (0)
#define PG8_LDA(dst, b, h) do { _Pragma("unroll") for (int m = 0; m < 4; ++m) _Pragma("unroll") for (int k = 0; k < 2; ++k) dst[m][k] = *(const LAS bf16x8*)(lds + PG8_SA(b, h) + aoff + m * 2048 + k * 1024); } while (0)
#define PG8_LDB(dst, b, h) do { _Pragma("unroll") for (int n = 0; n < 2; ++n) _Pragma("unroll") for (int k = 0; k < 2; ++k) dst[n][k] = *(const LAS bf16x8*)(lds + PG8_SB(b, h) + boff + n * 2048 + k * 1024); } while (0)
#define PG8_MMA(ai, bj, At, Bt) do { __builtin_amdgcn_s_setprio(1); _Pragma("unroll") for (int m = 0; m < 4; ++m) _Pragma("unroll") for (int n = 0; n < 2; ++n) { \
        if constexpr (FP8) acc[ai][bj][m][n] = __builtin_amdgcn_mfma_scale_f32_16x16x128_f8f6f4(cat8(Bt[n][0], Bt[n][1]), cat8(At[m][0], At[m][1]), acc[ai][bj][m][n], 0, 0, 0, 0, 0, 0);     \
        else { _Pragma("unroll") for (int k = 0; k < 2; ++k) acc[ai][bj][m][n] = __builtin_amdgcn_mfma_f32_16x16x32_bf16(Bt[n][k], At[m][k], acc[ai][bj][m][n], 0, 0, 0); } } __builtin_amdgcn_s_setprio(0); } while (0)
#define PG8_WAIT_V(n) asm volatile("s_waitcnt vmcnt(" #n ")" ::: "memory")
#define PG8_WAIT_L(n) asm volatile("s_waitcnt lgkmcnt(" #n ")" ::: "memory")
#define PG8_BAR __builtin_amdgcn_s_barrier()
#define PG8_SCHED __builtin_amdgcn_sched_barrier(0)
    Unit cur, nxt; int ui = 0;
    if (!S.next(0, cur)) return;
    LAS float* const sctab = (LAS float*)(lds + STAGE_BYTES + 1024 + 16384);
    int sb = 0;
    if constexpr (SCL) { PG8_SCFILL(0, E.scales(cur)); }
    f32x4 acc[2][2][4][2];
#pragma unroll
    for (int a = 0; a < 2; ++a)
#pragma unroll
        for (int b = 0; b < 2; ++b)
#pragma unroll
            for (int m = 0; m < 4; ++m)
#pragma unroll
                for (int n = 0; n < 2; ++n) { double z0_, z1_; asm volatile("v_mov_b64 %0, 0\n\tv_mov_b64 %1, 0" : "=v"(z0_), "=v"(z1_)); acc[a][b][m][n] = __builtin_bit_cast(f32x4, (f64x2z){z0_, z1_}); }
    bf16x8 At[4][2], B0[2][2], B1[2][2];
    const char* cA = cur.a; const char* cB = cur.b;
    if constexpr (GATHER) { const int pm0 = __builtin_amdgcn_readfirstlane(cur.pm); PG8_GFILL(0, gro + 256 * pm0); }
    PG8_STAGE(PG8_SB(0, 0), cB, voffB); PG8_STAGE(PG8_SB(0, 1), cB + hstep, voffB);
    if constexpr (GATHER) PG8_WAIT_V(4);
    PG8_STAGE_A(PG8_SA(0, 0), cA, 0, 0); PG8_STAGE_A(PG8_SA(0, 1), cA, 1, 0);
    if (wr == 1) PG8_BAR;
    PG8_WAIT_V(2); PG8_BAR;
    PG8_STAGE(PG8_SB(1, 0), cB + kstep, voffB); PG8_STAGE_A(PG8_SA(1, 0), cA + kstep, 0, 0); PG8_STAGE(PG8_SB(1, 1), cB + hstep + kstep, voffB);
    PG8_WAIT_V(6); PG8_BAR;
    for (;;) {
        const bool has_next = S.next(ui + 1, nxt);
        const int sbn = (sb == 2) ? 0 : sb + 1;
        if constexpr (SCL) { if (has_next) PG8_SCFILL(sbn, E.scales(nxt)); }
        const char* nA = has_next ? nxt.a : cA + (size_t)(nt - 2) * kstep; const char* nB = has_next ? nxt.b : cB + (size_t)(nt - 2) * kstep;
        const int tbc = ui & 1, tbn = has_next ? (tbc ^ 1) : tbc;
        if constexpr (GATHER) { if (has_next) PG8_GFILL(tbn, gro + 256 * nxt.pm); }
        for (int t = 0; t < nt; t += 2) {
            const bool last = (t == nt - 2);
            const char* a1 = cA + (size_t)(t + 1) * kstep;
            const char* a2 = last ? nA : cA + (size_t)(t + 2) * kstep; const char* b2 = last ? nB : cB + (size_t)(t + 2) * kstep;
            const char* a3 = a2 + kstep; const char* b3 = b2 + kstep;
            const int tb2 = last ? tbn : tbc;
            PG8_LDB(B0, 0, 0); PG8_LDB(B1, 0, 1); PG8_SCHED; PG8_LDA(At, 0, 0); PG8_STAGE_A(PG8_SA(1, 1), a1, 1, tbc);
            PG8_WAIT_V(8); PG8_WAIT_L(0); PG8_BAR; PG8_MMA(0, 0, At, B0); PG8_MMA(0, 1, At, B1); PG8_BAR; PG8_SCHED;
            PG8_LDA(At, 0, 1); PG8_STAGE(PG8_SB(0, 0), b2, voffB); PG8_STAGE(PG8_SB(0, 1), b2 + hstep, voffB); PG8_STAGE_A(PG8_SA(0, 0), a2, 0, tb2);
            PG8_WAIT_V(8); PG8_WAIT_L(0); PG8_BAR; PG8_MMA(1, 0, At, B0); PG8_MMA(1, 1, At, B1); PG8_BAR; PG8_SCHED;
            PG8_LDB(B0, 1, 0); PG8_LDB(B1, 1, 1); PG8_SCHED; PG8_LDA(At, 1, 0); PG8_STAGE_A(PG8_SA(0, 1), a2, 1, tb2);
            PG8_WAIT_V(8); PG8_WAIT_L(0); PG8_BAR; PG8_MMA(0, 0, At, B0); PG8_MMA(0, 1, At, B1); PG8_BAR; PG8_SCHED;
            PG8_LDA(At, 1, 1); PG8_STAGE(PG8_SB(1, 0), b3, voffB); PG8_STAGE(PG8_SB(1, 1), b3 + hstep, voffB); PG8_STAGE_A(PG8_SA(1, 0), a3, 0, tb2);
            PG8_WAIT_V(8); PG8_WAIT_L(0); PG8_BAR; PG8_MMA(1, 0, At, B0); PG8_MMA(1, 1, At, B1); PG8_BAR; PG8_SCHED;
        }
        if (wr == 0) PG8_BAR;
        { int le_; asm volatile("v_mbcnt_lo_u32_b32 %0, -1, 0\n\tv_mbcnt_hi_u32_b32 %0, -1, %0" : "=v"(le_)); E(acc, cur, wr, wc, le_ & 15, le_ >> 4, (const LAS float*)(sctab + sb * 256)); }
        if (!has_next) break;
#pragma unroll
        for (int a = 0; a < 2; ++a)
#pragma unroll
            for (int b = 0; b < 2; ++b)
#pragma unroll
                for (int m = 0; m < 4; ++m)
#pragma unroll
                    for (int n = 0; n < 2; ++n) { double z0_, z1_; asm volatile("v_mov_b64 %0, 0\n\tv_mov_b64 %1, 0" : "=v"(z0_), "=v"(z1_)); acc[a][b][m][n] = __builtin_bit_cast(f32x4, (f64x2z){z0_, z1_}); }
        cur = nxt; cA = nA; cB = nB; ++ui; sb = sbn;
        if (wr == 1) PG8_BAR;
    }
    PG8_WAIT_V(0);
    PG8_BAR;
#undef PG8_SA
#undef PG8_SB
#undef PG8_STAGE
#undef PG8_STAGE_A
#undef PG8_DMA16
#undef PG8_GFILL
#undef PG8_SCFILL
#undef PG8_LDA
#undef PG8_LDB
#undef PG8_MMA
#undef PG8_WAIT_V
#undef PG8_WAIT_L
#undef PG8_BAR
#undef PG8_SCHED
}

__device__ __forceinline__ void tile_of(int L, int n, int nN, int& pm, int& pn) {
    const int q = n >> 3, w = (L & 7) * q + (L >> 3);
    const int nig = 8 * nN, gid = w / nig, rem = w % nig;
    pm = gid * 8 + (rem & 7); pn = rem >> 3;
}

__device__ __forceinline__ f32x4 ld4s(const float* p) { return *(const f32x4*)p; }
__device__ __forceinline__ f32x4 ld4s(const LAS float* p) { return *(const LAS f32x4*)p; }
template <class T> struct IdT { typedef T type; };
template <bool ROWS, bool COLS, class SP = const float*>
__device__ __forceinline__ void store_tile_bf16(const f32x4 (&acc)[2][2][4][2], bf16* base, int ldc, typename IdT<SP>::type rowscale, typename IdT<SP>::type colscale, int wr, int wc, int fr, int fq, const float gscale = 1.f) {
    const int row0 = wr * 64 + fr, col0 = wc * 32 + 8 * fq;
    f32x4 cs[2][2];
#pragma unroll
    for (int bj = 0; bj < 2; ++bj)
#pragma unroll
        for (int n = 0; n < 2; ++n) cs[bj][n] = COLS ? ld4s(colscale + col0 + bj * HALF + 4 * n) : (f32x4){1.f, 1.f, 1.f, 1.f};
#pragma unroll
    for (int ai = 0; ai < 2; ++ai)
#pragma unroll
        for (int m = 0; m < 4; ++m) {
            const int r = row0 + ai * HALF + m * 16;
            const float rs = ROWS ? rowscale[r] * gscale : 1.f;
            bf16* rowp = base + (size_t)r * ldc + col0;
#pragma unroll
            for (int bj = 0; bj < 2; ++bj) {
                f32x4 v0 = acc[ai][bj][m][0], v1 = acc[ai][bj][m][1];
                if (COLS) { v0 = v0 * cs[bj][0]; v1 = v1 * cs[bj][1]; }
                if (ROWS) { v0 = v0 * rs; v1 = v1 * rs; }
                u32x4 w; w.x = cvt_pk_bf16(v0[0], v0[1]); w.y = cvt_pk_bf16(v0[2], v0[3]); w.z = cvt_pk_bf16(v1[0], v1[1]); w.w = cvt_pk_bf16(v1[2], v1[3]);
                *(u32x4*)(rowp + bj * HALF) = w; } }
}
}
using pg8::Unit;
typedef const f32x4 (&AccRef)[2][2][4][2];

struct Args { const float* in[13]; float* out; unsigned char* ws; int ph_lo, ph_hi; };
struct Frame {
    LAS unsigned char* lds; int tid, lane, wave, G, gw, NGW, bx;
    const float *x, *g1, *w_in, *w_f, *w_p, *p_s, *w_out, *g2, *w_r, *w_g, *w_u, *w_d, *gf;
    float* out; unsigned char* ws;
};

struct OrdFold {
    unsigned char* ws; int stage, G, c;
    __device__ __forceinline__ bool next(int i, Unit& u) const {
        const int L = i * G + c; if (L >= 128) return false;
        const int l = L >> 6, r = L & 63, mt = r & 7, q = r >> 3;
        u.pm = L; u.pn = 0;
        if (stage == 0) {
            const int g = q & 3;
            u.a = (const char*)((const bf16*)(ws + WS_WOT) + ((size_t)(l * 8 + q) * D + 256 * mt) * 256);
            u.b = (const char*)((const bf16*)(ws + (q < 4 ? WS_WF : WS_WPS)) + (size_t)(l * 4 + g) * 65536);
        } else {
            const int g = q >> 1, nt = q & 1;
            u.a = (const char*)((const bf16*)(ws + WS_TT) + ((size_t)(l * 4 + g) * D + 256 * mt) * 256);
            u.b = (const char*)((const bf16*)(ws + WS_CCS) + (size_t)nt * 65536);
        }
        return true;
    }
};
struct EpiFold {
    unsigned char* ws; int stage;
    __device__ __forceinline__ const float* scales(const Unit&) const { return nullptr; }
    __device__ __forceinline__ void operator()(AccRef acc, const Unit& u, int wr, int wc, int fr, int fq, const LAS float* sc) const {
        const int L = u.pm, l = L >> 6, r = L & 63, mt = r & 7, q = r >> 3;
        bf16* wo2 = (bf16*)(ws + WS_WO2) + ((size_t)(l * 2) * D + 256 * mt) * 2048;
        if (stage == 0) { const int g = q & 3;
            if (q < 4) pg8::store_tile_bf16<false, false>(acc, (bf16*)(ws + WS_TT) + ((size_t)(l * 4 + g) * D + 256 * mt) * 256, 256, nullptr, nullptr, wr, wc, fr, fq);
            else { pg8::store_tile_bf16<false, false>(acc, wo2 + 1024 + 256 * g, 2048, nullptr, nullptr, wr, wc, fr, fq);
                   pg8::store_tile_bf16<false, false>(acc, wo2 + (size_t)D * 2048 + 1024 + 256 * g, 2048, nullptr, nullptr, wr, wc, fr, fq); } }
        else { const int g = q >> 1, nt = q & 1; pg8::store_tile_bf16<false, false>(acc, wo2 + (size_t)nt * D * 2048 + 256 * g, 2048, nullptr, nullptr, wr, wc, fr, fq); }
    }
};
struct OrdWin {
    unsigned char* ws; int l, G, c, u0, u1;
    __device__ __forceinline__ bool next(int i, Unit& u) const {
        i += u0; if (i >= u1) return false;
        const int L = i * G + c; if (L >= 512) return false;
        pg8::tile_of(L, 512, 8, u.pm, u.pn);
        const char* xb = (const char*)((const bf16*)(ws + WS_XB) + (size_t)(256 * u.pm) * D);
        const char* w = (const char*)((const bf16*)(ws + WS_WIN) + (size_t)l * D * D + (size_t)(256 * u.pn) * D);
        if (u.pn < 4) { u.a = w; u.b = xb; } else { u.a = xb; u.b = w; }
        return true;
    }
};
struct EpiWin {
    unsigned char* ws;
    __device__ __forceinline__ const float* scales(const Unit& u) const { return (const float*)(ws + WS_RMS1) + 256 * u.pm; }
    __device__ __forceinline__ void operator()(AccRef acc, const Unit& u, int wr, int wc, int fr, int fq, const LAS float* sc) const {
        if (u.pn < 4) { const int b = u.pm >> 4, l0 = (u.pm & 15) * 256;
            pg8::store_tile_bf16<false, true, const LAS float*>(acc, (bf16*)(ws + WS_UT) + ((size_t)(b * 1024 + 256 * u.pn)) * SEQ + l0, SEQ, nullptr, sc, wr, wc, fr, fq); }
        else pg8::store_tile_bf16<true, false, const LAS float*>(acc, (bf16*)(ws + WS_UP) + (size_t)(256 * u.pm) * 1024 + 256 * (u.pn - 4), 1024, sc, nullptr, wr, wc, fr, fq);
    }
};
struct OrdDft {
    unsigned char* ws; int G, c, u0, u1;
    __device__ __forceinline__ bool next(int i, Unit& u) const {
        i += u0; if (i >= u1) return false;
        const int L = i * G + c; if (L >= 256) return false;
        u.pm = L >> 2; u.pn = L & 3;
        const int b = u.pm >> 4, k1 = u.pm & 15, ksrc = (k1 <= 8) ? k1 : 16 - k1;
        u.a = (const char*)(ws + WS_CS) + (size_t)k1 * (256 * 512 * 2);
        u.b = (const char*)(ws + WS_ZT) + ((size_t)(b * 9 + ksrc) * 1024 + 256 * u.pn) * 1024;
        return true;
    }
};
struct EpiDft {
    unsigned char* ws;
    __device__ __forceinline__ const float* scales(const Unit&) const { return nullptr; }
    __device__ __forceinline__ void operator()(AccRef acc, const Unit& u, int wr, int wc, int fr, int fq, const LAS float* sc) const {
        const int b = u.pm >> 4, k1 = u.pm & 15;
#pragma unroll
        for (int ai = 0; ai < 2; ++ai) {
            bf16* base = (bf16*)(ws + WS_F) + ((size_t)(ai * NB + b) * KH) * 2048 + 256 * u.pn + wc * 32 + 8 * fq;
#pragma unroll
            for (int m = 0; m < 4; ++m) {
                const int k = k1 + 16 * (wr * 64 + fr + m * 16);
#pragma unroll
                for (int bj = 0; bj < 2; ++bj) {
                    const f32x4 v0 = acc[ai][bj][m][0], v1 = acc[ai][bj][m][1];
                    u32x4 w; w.x = cvt_pk_bf16(v0[0], v0[1]); w.y = cvt_pk_bf16(v0[2], v0[3]); w.z = cvt_pk_bf16(v1[0], v1[1]); w.w = cvt_pk_bf16(v1[2], v1[3]);
                    *(u32x4*)(base + (size_t)k * 2048 + bj * 128) = w; } } }
    }
};
struct OrdWout {
    unsigned char* ws; int l, G, c, u0, u1;
    __device__ __forceinline__ bool next(int i, Unit& u) const {
        i += u0; if (i >= u1) return false;
        if (i >= 2 || c >= 256) return false;
        int pm, pn; pg8::tile_of(c, 256, 8, pm, pn);
        const int b = pm >> 3, kt = pm & 7;
        u.a = (const char*)((const bf16*)(ws + WS_F) + ((size_t)(i * NB + b) * KH + 256 * kt) * 2048);
        u.b = (const char*)((const bf16*)(ws + WS_WO2) + ((size_t)(l * 2 + i) * D + 256 * pn) * 2048);
        u.pm = pm | (i << 8); u.pn = pn;
        return true;
    }
};
struct EpiSD {
    unsigned char* ws; int bx;
    __device__ __forceinline__ const float* scales(const Unit&) const { return nullptr; }
    __device__ __forceinline__ void operator()(AccRef acc, const Unit& u, int wr, int wc, int fr, int fq, const LAS float* sc) const {
        bf16* ss = (bf16*)(ws + WS_SS) + (size_t)bx * 65536;
        if ((u.pm >> 8) == 0) { pg8::store_tile_bf16<false, false>(acc, ss, 256, nullptr, nullptr, wr, wc, fr, fq); return; }
        const int pm = u.pm & 255, b = pm >> 3, kt = pm & 7;
        const int row0 = wr * 64 + fr, col0 = wc * 32 + 8 * fq;
        bf16* xbb = (bf16*)(ws + WS_XB) + (size_t)(b * SEQ) * D + 256 * u.pn + col0; unsigned char* x8b = ws + WS_XS + (size_t)(b * SEQ) * D + 256 * u.pn + col0;
        u32x4 sw[2][2], r0[2][2], r1[2][2];
#define SD_LOAD(bf_, it_) do { const int r_ = row0 + ((it_) >> 2) * 128 + ((it_) & 3) * 16, k_ = 256 * kt + r_, km_ = (k_ == 0) ? 0 : SEQ - k_; \
            _Pragma("unroll") for (int bj = 0; bj < 2; ++bj) { sw[bf_][bj] = *(const u32x4*)(ss + (size_t)r_ * 256 + col0 + bj * 128); \
                r0[bf_][bj] = *(const u32x4*)(xbb + (size_t)k_ * D + bj * 128); r1[bf_][bj] = *(const u32x4*)(xbb + (size_t)km_ * D + bj * 128); } } while (0)
        SD_LOAD(0, 0);
#pragma unroll
        for (int it = 0; it < 8; ++it) {
            const int ai = it >> 2, m = it & 3, bf = it & 1;
            const int r = row0 + ai * 128 + m * 16, k = 256 * kt + r, km = (k == 0) ? 0 : SEQ - k;
            if (it + 1 < 8) SD_LOAD(bf ^ 1, it + 1);
#pragma unroll
            for (int bj = 0; bj < 2; ++bj) {
                const u32x4 swv = sw[bf][bj];
                const f32x4 s0 = (f32x4){bf_lo(swv.x), bf_hi(swv.x), bf_lo(swv.y), bf_hi(swv.y)}, s1 = (f32x4){bf_lo(swv.z), bf_hi(swv.z), bf_lo(swv.w), bf_hi(swv.w)};
                const f32x4 d0 = acc[ai][bj][m][0], d1 = acc[ai][bj][m][1];
                { const u32x4 rr = r0[bf][bj];
                  const f32x4 v0 = (s0 + d0) + (f32x4){bf_lo(rr.x), bf_hi(rr.x), bf_lo(rr.y), bf_hi(rr.y)}, v1 = (s1 + d1) + (f32x4){bf_lo(rr.z), bf_hi(rr.z), bf_lo(rr.w), bf_hi(rr.w)};
                  u32x4 w; w.x = cvt_pk_bf16(v0[0], v0[1]); w.y = cvt_pk_bf16(v0[2], v0[3]); w.z = cvt_pk_bf16(v1[0], v1[1]); w.w = cvt_pk_bf16(v1[2], v1[3]);
                  *(u32x4*)(xbb + (size_t)k * D + bj * 128) = w;
                  u32x2 q; q.x = pk4_fp8(v0[0], v0[1], v0[2], v0[3]); q.y = pk4_fp8(v1[0], v1[1], v1[2], v1[3]); *(u32x2*)(x8b + (size_t)k * D + bj * 128) = q; }
                if (k != 0) { const u32x4 rr = r1[bf][bj];
                  const f32x4 v0 = (s0 - d0) + (f32x4){bf_lo(rr.x), bf_hi(rr.x), bf_lo(rr.y), bf_hi(rr.y)}, v1 = (s1 - d1) + (f32x4){bf_lo(rr.z), bf_hi(rr.z), bf_lo(rr.w), bf_hi(rr.w)};
                  u32x4 w; w.x = cvt_pk_bf16(v0[0], v0[1]); w.y = cvt_pk_bf16(v0[2], v0[3]); w.z = cvt_pk_bf16(v1[0], v1[1]); w.w = cvt_pk_bf16(v1[2], v1[3]);
                  *(u32x4*)(xbb + (size_t)km * D + bj * 128) = w;
                  u32x2 q; q.x = pk4_fp8(v0[0], v0[1], v0[2], v0[3]); q.y = pk4_fp8(v1[0], v1[1], v1[2], v1[3]); *(u32x2*)(x8b + (size_t)km * D + bj * 128) = q; }
            }
            asm volatile("" ::: "memory");
        }
#undef SD_LOAD
    }
};
struct OrdFfn1 {
    unsigned char* ws; int l, G, c, u0, u1;
    __device__ __forceinline__ bool next(int i, Unit& u) const {
        i += u0; if (i >= u1) return false;
        const int L = i * G + c; if (L >= 2048) return false;
        pg8::tile_of(L, 2048, 16, u.pm, u.pn);
        u.a = (const char*)(ws + WS_XS);
        u.b = (const char*)(ws + WS_WGU) + ((size_t)(l * NE + (u.pm >> 3)) * 4096 + 256 * u.pn) * D;
        return true;
    }
};
struct EpiSwiglu {
    unsigned char* ws;
    __device__ __forceinline__ const float* scales(const Unit& u) const { return (const float*)(ws + WS_SRS) + 256 * u.pm; }
    __device__ __forceinline__ void operator()(AccRef acc, const Unit& u, int wr, int wc, int fr, int fq, const LAS float* sc) const {
        unsigned char* base = ws + WS_HID + (size_t)(256 * u.pm) * D + 128 * u.pn;
        const int row0 = wr * 64 + fr, col0 = wc * 32 + 8 * fq;
#pragma unroll
        for (int ai = 0; ai < 2; ++ai)
#pragma unroll
            for (int m = 0; m < 4; ++m) {
                const int r = row0 + ai * 128 + m * 16;
                const float rs = sc[r] * (1.0f / W8_SCALE), kt = rs * -1.44269504089f, ik2 = __builtin_amdgcn_rcpf(rs * rs * H8_SCALE);
                float h[8];
#pragma unroll
                for (int n = 0; n < 2; ++n)
#pragma unroll
                    for (int j = 0; j < 4; j += 2) {
                        const f32x2 ag = (f32x2){acc[ai][0][m][n][j], acc[ai][0][m][n][j + 1]}, au = (f32x2){acc[ai][1][m][n][j], acc[ai][1][m][n][j + 1]};
                        const f32x2 t = ag * kt;
                        f32x2 d; d.x = __builtin_amdgcn_exp2f(t.x); d.y = __builtin_amdgcn_exp2f(t.y);
                        d = d * ik2 + ik2;
                        f32x2 rc; rc.x = __builtin_amdgcn_rcpf(d.x); rc.y = __builtin_amdgcn_rcpf(d.y);
                        const f32x2 hv = (ag * au) * rc;
                        h[n * 4 + j] = __builtin_amdgcn_fmed3f(hv.x, -448.f, 448.f); h[n * 4 + j + 1] = __builtin_amdgcn_fmed3f(hv.y, -448.f, 448.f);
                    }
                u32x2 w; w.x = pk4_fp8(h[0], h[1], h[2], h[3]); w.y = pk4_fp8(h[4], h[5], h[6], h[7]);
                *(u32x2*)(base + (size_t)r * D + col0) = w; }
    }
};
struct OrdFfn2 {
    unsigned char* ws; int l, G, c, u0, u1;
    __device__ __forceinline__ bool next(int i, Unit& u) const {
        i += u0; if (i >= u1) return false;
        const int L = i * G + c; if (L >= 1024) return false;
        pg8::tile_of(L, 1024, 8, u.pm, u.pn);
        u.a = (const char*)(ws + WS_HID) + (size_t)(256 * u.pm) * D;
        u.b = (const char*)(ws + WS_WD) + ((size_t)(l * NE + (u.pm >> 3)) * D + 256 * u.pn) * D;
        return true;
    }
};
struct EpiDown {
    unsigned char* ws;
    __device__ __forceinline__ const float* scales(const Unit& u) const { return (const float*)(ws + WS_SGT) + 256 * u.pm; }
    __device__ __forceinline__ void operator()(AccRef acc, const Unit& u, int wr, int wc, int fr, int fq, const LAS float* sc) const {
        unsigned char* base = ws + WS_YS + (size_t)(256 * u.pm) * D + 256 * u.pn;
        const int row0 = wr * 64 + fr, col0 = wc * 32 + 8 * fq;
#pragma unroll
        for (int ai = 0; ai < 2; ++ai)
#pragma unroll
            for (int m = 0; m < 4; ++m) {
                const int r = row0 + ai * 128 + m * 16;
                const float scl = sc[r] * (YS8_SCALE / (W8_SCALE * H8_SCALE));
#pragma unroll
                for (int bj = 0; bj < 2; ++bj) { f32x4 v0 = acc[ai][bj][m][0] * scl, v1 = acc[ai][bj][m][1] * scl;
#pragma unroll
                    for (int j = 0; j < 4; ++j) { v0[j] = __builtin_amdgcn_fmed3f(v0[j], -448.f, 448.f); v1[j] = __builtin_amdgcn_fmed3f(v1[j], -448.f, 448.f); }
                    u32x2 q; q.x = pk4_fp8(v0[0], v0[1], v0[2], v0[3]); q.y = pk4_fp8(v1[0], v1[1], v1[2], v1[3]);
                    *(u32x2*)(base + (size_t)r * D + col0 + bj * 128) = q; } }
    }
};

__device__ __forceinline__ void tr_tile(const float* W, int ldw, const float* ks, bf16* dst, int dld, int k0, int n0, int drow0, int kd0, int lane) {
    const int kr = lane >> 4, nq = lane & 15;
    const float* src = W + (size_t)(k0 + 16 * kr) * ldw + n0 + 4 * nq;
    f32x4 v[16];
#pragma unroll
    for (int i = 0; i < 16; ++i) v[i] = __builtin_nontemporal_load((const f32x4*)(src + (size_t)i * ldw));
    if (ks) {
        const f32x4* kp = (const f32x4*)(ks + k0 + 16 * kr);
#pragma unroll
        for (int i4 = 0; i4 < 4; ++i4) { const f32x4 s = kp[i4];
#pragma unroll
            for (int j = 0; j < 4; ++j) v[i4 * 4 + j] = v[i4 * 4 + j] * s[j]; }
    }
#pragma unroll
    for (int j = 0; j < 4; ++j) {
        bf16* o = dst + (size_t)(drow0 + 4 * nq + j) * dld + kd0 + 16 * kr;
        u32x4 w0, w1;
        w0.x = cvt_pk_bf16(v[0][j], v[1][j]); w0.y = cvt_pk_bf16(v[2][j], v[3][j]); w0.z = cvt_pk_bf16(v[4][j], v[5][j]); w0.w = cvt_pk_bf16(v[6][j], v[7][j]);
        w1.x = cvt_pk_bf16(v[8][j], v[9][j]); w1.y = cvt_pk_bf16(v[10][j], v[11][j]); w1.z = cvt_pk_bf16(v[12][j], v[13][j]); w1.w = cvt_pk_bf16(v[14][j], v[15][j]);
        *(u32x4*)o = w0; *(u32x4*)(o + 8) = w1;
    }
}
struct Tr8 { const float* wg; const float* wu; const float* wd; const float* g2; unsigned char* ws; LAS unsigned char* lds; int wave, lane; };
__device__ __forceinline__ void tr8_load(const Tr8& T, int lw, int it, f32x4 (&v)[16], f32x4 (&kq)[4]) {
    const int mid = it >> 7, r = it & 127, n0 = (r & 7) * 256, k0 = (r >> 3) * 128, le = lw * 16 + (mid & 15), kind = mid >> 4;
    { const float* ks = T.g2 + (le >> 4) * D + k0 + 16 * T.wave;
#pragma unroll
      for (int q = 0; q < 4; ++q) kq[q] = (kind < 2) ? *(const f32x4*)(ks + 4 * q) : (f32x4){1.f, 1.f, 1.f, 1.f}; }
    const float* src = (kind == 0 ? T.wg : kind == 1 ? T.wu : T.wd) + (size_t)le * D * D + (size_t)(k0 + 16 * T.wave) * D + n0 + 4 * T.lane;
#pragma unroll
    for (int i = 0; i < 16; ++i) v[i] = __builtin_nontemporal_load((const f32x4*)(src + (size_t)i * D));
}
__device__ __forceinline__ void tr8_proc(const Tr8& T, int lw, int it, f32x4 (&v)[16], const f32x4 (&kq)[4], int p) {
    constexpr int PITCH = 144, IMG = 256 * PITCH;
    const int mid = it >> 7, r = it & 127, n0 = (r & 7) * 256, k0 = (r >> 3) * 128, le = lw * 16 + (mid & 15), kind = mid >> 4;
#pragma unroll
    for (int i = 0; i < 16; ++i) v[i] = v[i] * (kq[i >> 2][i & 3] * W8_SCALE);
    LAS unsigned char* img = T.lds + p * IMG;
#pragma unroll
    for (int j = 0; j < 4; ++j) { u32x4 w;
        w.x = pk4_fp8(v[0][j], v[1][j], v[2][j], v[3][j]); w.y = pk4_fp8(v[4][j], v[5][j], v[6][j], v[7][j]);
        w.z = pk4_fp8(v[8][j], v[9][j], v[10][j], v[11][j]); w.w = pk4_fp8(v[12][j], v[13][j], v[14][j], v[15][j]);
        *(LAS u32x4*)(img + (4 * T.lane + j) * PITCH + 16 * T.wave) = w; }
    asm volatile("s_waitcnt lgkmcnt(0)" ::: "memory"); __builtin_amdgcn_s_barrier(); asm volatile("" ::: "memory");
    unsigned char* dst = (kind < 2) ? T.ws + WS_WGU + (size_t)le * 4096 * D : T.ws + WS_WD + (size_t)le * D * D;
#pragma unroll
    for (int q = 0; q < 4; ++q) {
        const int row = 32 * T.wave + 8 * q + (T.lane >> 3), ch = T.lane & 7, n = n0 + row;
        const int drow = (kind < 2) ? ((n >> 7) * 256 + (n & 127) + (kind == 1 ? 128 : 0)) : n;
        const u32x4 w = *(const LAS u32x4*)(img + row * PITCH + 16 * ch);
        __builtin_nontemporal_store(w, (u32x4*)(dst + (size_t)drow * D + k0 + 16 * ch)); }
}
__device__ __forceinline__ void p_conv(Frame& F, int j0, int j1) {
    const Tr8 T{F.w_g, F.w_u, F.w_d, F.g2, F.ws, F.lds, F.wave, F.lane};
    f32x4 va[16], vb[16], ka[4], kb[4];
    int j = j0, p = 0;
#define CV_LW(j_) ((j_) >= 24 ? 1 : 0)
#define CV_IT(j_) (((j_) - 24 * CV_LW(j_)) * F.G + F.bx)
    if (j < j1) tr8_load(T, CV_LW(j), CV_IT(j), va, ka);
    while (j < j1) {
        const int j2 = j + 1; if (j2 < j1) tr8_load(T, CV_LW(j2), CV_IT(j2), vb, kb);
        tr8_proc(T, CV_LW(j), CV_IT(j), va, ka, p); p ^= 1;
        if (j2 >= j1) break;
        const int j3 = j2 + 1; if (j3 < j1) tr8_load(T, CV_LW(j3), CV_IT(j3), va, ka);
        tr8_proc(T, CV_LW(j2), CV_IT(j2), vb, kb, p); p ^= 1;
        j = j3;
    }
    __syncthreads();
#undef CV_LW
#undef CV_IT
}
__device__ __forceinline__ void add8_fp8(f32x4 (&v)[2], u32x2 w, float sc) {
    const f32x2 a = __builtin_amdgcn_cvt_pk_f32_fp8((int)w.x, false), b = __builtin_amdgcn_cvt_pk_f32_fp8((int)w.x, true), c = __builtin_amdgcn_cvt_pk_f32_fp8((int)w.y, false), d = __builtin_amdgcn_cvt_pk_f32_fp8((int)w.y, true);
    v[0] = v[0] + (f32x4){a.x, a.y, b.x, b.y} * sc; v[1] = v[1] + (f32x4){c.x, c.y, d.x, d.y} * sc;
}
__device__ __forceinline__ void row_pass(Frame& F, int row, bool from_x, bool final_out) {
    const int lane = F.lane;
    f32x4 v[4][2];
    if (from_x) { const float* sp = F.x + (size_t)row * D + 8 * lane;
#pragma unroll
        for (int j = 0; j < 4; ++j) { v[j][0] = *(const f32x4*)(sp + 512 * j); v[j][1] = *(const f32x4*)(sp + 512 * j + 4); } }
    else {
        const int* sel = (const int*)(F.ws + WS_SEL) + (size_t)row * NE;
        const int sv = (lane < NE) ? sel[lane] : -1;
        const bf16* bp = (const bf16*)(F.ws + WS_XB) + (size_t)row * D + 8 * lane;
#pragma unroll
        for (int j = 0; j < 4; ++j) { const u32x4 w = *(const u32x4*)(bp + 512 * j);
            v[j][0] = (f32x4){bf_lo(w.x), bf_hi(w.x), bf_lo(w.y), bf_hi(w.y)}; v[j][1] = (f32x4){bf_lo(w.z), bf_hi(w.z), bf_lo(w.w), bf_hi(w.w)}; }
        unsigned long long m = __ballot(sv >= 0);
        const int b = row >> 12;
        const unsigned char* ybase = F.ws + WS_YS + (size_t)(b * CAP) * D + 8 * lane;
        while (m) {
            const int e0 = __builtin_ctzll(m); m &= m - 1;
            const bool two = (m != 0ull);
            const int e1 = two ? __builtin_ctzll(m) : e0; if (two) m &= m - 1;
            const int s0 = __builtin_amdgcn_readlane(sv, e0), s1 = __builtin_amdgcn_readlane(sv, e1);
            const unsigned char* y0 = ybase + ((size_t)e0 * ESL + s0) * D; const unsigned char* y1 = ybase + ((size_t)e1 * ESL + s1) * D;
            u32x2 w0[4], w1[4];
#pragma unroll
            for (int j = 0; j < 4; ++j) { w0[j] = *(const u32x2*)(y0 + 512 * j); w1[j] = *(const u32x2*)(y1 + 512 * j); }
#pragma unroll
            for (int j = 0; j < 4; ++j) add8_fp8(v[j], w0[j], 1.0f / YS8_SCALE);
            if (two) {
#pragma unroll
                for (int j = 0; j < 4; ++j) add8_fp8(v[j], w1[j], 1.0f / YS8_SCALE); }
        }
    }
    float ss = 0.f;
#pragma unroll
    for (int j = 0; j < 4; ++j)
#pragma unroll
        for (int h = 0; h < 2; ++h) ss += (v[j][h][0] * v[j][h][0] + v[j][h][1] * v[j][h][1]) + (v[j][h][2] * v[j][h][2] + v[j][h][3] * v[j][h][3]);
    const float inv = 1.f / sqrtf(wave_sum(ss, lane) * (1.f / D) + RMS_EPS);
    if (final_out) {
        float* op = F.out + (size_t)row * D + 8 * lane; const float* gp = F.gf + 8 * lane;
        f32x4 gq[4][2];
#pragma unroll
        for (int j = 0; j < 4; ++j) { gq[j][0] = *(const f32x4*)(gp + 512 * j); gq[j][1] = *(const f32x4*)(gp + 512 * j + 4); }
#pragma unroll
        for (int j = 0; j < 4; ++j)
#pragma unroll
            for (int h = 0; h < 2; ++h) *(f32x4*)(op + 512 * j + 4 * h) = v[j][h] * inv * gq[j][h];
    } else {
        bf16* bp = (bf16*)(F.ws + WS_XB) + (size_t)row * D + 8 * lane;
#pragma unroll
        for (int j = 0; j < 4; ++j) { u32x4 w; w.x = cvt_pk_bf16(v[j][0][0], v[j][0][1]); w.y = cvt_pk_bf16(v[j][0][2], v[j][0][3]); w.z = cvt_pk_bf16(v[j][1][0], v[j][1][1]); w.w = cvt_pk_bf16(v[j][1][2], v[j][1][3]);
            *(u32x4*)(bp + 512 * j) = w; }
        if (lane == 0) ((float*)(F.ws + WS_RMS1))[row] = inv;
    }
}
__device__ __forceinline__ bf16 f2bf(float v) { return (bf16)(cvt_pk_bf16(v, 0.f) & 0xffffu); }
__device__ __forceinline__ void p_prep(Frame& F) {
    LAS float* ctab = (LAS float*)F.lds;
    for (int i = F.tid; i < 4096; i += 512) ctab[i] = cospif((float)i * (1.0f / 2048.0f));
    __syncthreads();
    const int gt = F.bx * 512 + F.tid, NGT = F.G * 512;
    for (int i = gt; i < 512 * 256; i += NGT) {
        const int j = i >> 8, m = i & 255, ph = ((j & 255) * m) & 255;
        const float v = (j < 256) ? ctab[ph * 16] : -ctab[(ph * 16 + 3072) & 4095];
        ((bf16*)(F.ws + WS_CCS))[i] = f2bf(v * (1.0f / 1024.0f));
    }
    for (int i = gt; i < 16 * 256 * 512; i += NGT) {
        const int k1 = i >> 17, r = (i >> 9) & 255, kk = i & 511, p = r >> 7, k2 = r & 127, ri = kk >> 8, l2 = kk & 255, ph = ((k1 + 16 * k2) * l2) & 4095;
        const float c = ctab[ph], sn = ctab[(ph + 3072) & 4095], sg = (k1 <= 8) ? 1.f : -1.f;
        ((bf16*)(F.ws + WS_CS))[i] = f2bf(p == 0 ? (ri == 0 ? c : -sg * sn) : (ri == 0 ? sn : sg * c));
    }
    for (int i = gt; i < NL * 4 * 65536; i += NGT) {
        ((bf16*)(F.ws + WS_WF))[i] = f2bf(F.w_f[i]);
        const int lg = i >> 16, d = i & 255;
        ((bf16*)(F.ws + WS_WPS))[i] = f2bf(F.w_p[i] * F.p_s[lg * 256 + d]);
    }
    for (int i = gt; i < NL * NE * D; i += NGT) {
        const int l = i / (NE * D), e = (i / D) % NE, k = i % D;
        ((bf16*)(F.ws + WS_WR))[i] = f2bf(F.g2[l * D + k] * F.w_r[((size_t)l * D + k) * NE + e]);
    }
    for (int r = F.gw; r < T; r += F.NGW) row_pass(F, r, true, false);
    for (int it = F.gw; it < 4 * 1024; it += F.NGW) {
        const int mid = it >> 10, tile = it & 1023, k0 = (tile >> 5) * 64, n0 = (tile & 31) * 64;
        if (mid < 2) tr_tile(F.w_in + (size_t)mid * D * D, D, F.g1 + mid * D, (bf16*)(F.ws + WS_WIN) + (size_t)mid * D * D, D, k0, n0, n0, k0, F.lane);
        else tr_tile(F.w_out + (size_t)(mid - 2) * D * D, D, nullptr, (bf16*)(F.ws + WS_WOT) + ((size_t)(mid - 2) * 8 + (k0 >> 8)) * D * 256, 256, k0, n0, n0, k0 & 255, F.lane);
    }
}

__device__ __forceinline__ void ld8(const bf16* p, float (&o)[8]) { const u32x4 w = *(const u32x4*)p; o[0] = bf_lo(w.x); o[1] = bf_hi(w.x); o[2] = bf_lo(w.y); o[3] = bf_hi(w.y); o[4] = bf_lo(w.z); o[5] = bf_hi(w.z); o[6] = bf_lo(w.w); o[7] = bf_hi(w.w); }
template <int H, int MODE  >
__device__ __forceinline__ void pool_pass(const bf16* up, int r0, u32x4 (&pm)[8], bf16* fs, bf16* fd, float* ny, int t0) {
    u32x4 slot[8 + 2 * H];
#pragma unroll
    for (int s = 0; s < 8 + 2 * H; ++s) { const int row = r0 - H + s; slot[s] = (row >= 0 && row < SEQ) ? *(const u32x4*)(up + (size_t)row * 1024) : (u32x4){0u, 0u, 0u, 0u}; }
    float sum[8];
#pragma unroll
    for (int j = 0; j < 8; ++j) sum[j] = 0.f;
#pragma unroll
    for (int s = 0; s < 2 * H; ++s) { const u32x4 w = slot[s];
        sum[0] += bf_lo(w.x); sum[1] += bf_hi(w.x); sum[2] += bf_lo(w.y); sum[3] += bf_hi(w.y); sum[4] += bf_lo(w.z); sum[5] += bf_hi(w.z); sum[6] += bf_lo(w.w); sum[7] += bf_hi(w.w); }
#pragma unroll
    for (int i = 0; i < (MODE == 2 ? 1 : 8); ++i) {
        const int t = r0 + i;
        const int lo = (t - H) < 0 ? 0 : (t - H), hi = (t + H) > SEQ ? SEQ : (t + H);
        const float rc = (t < SEQ) ? 1.0f / (float)(hi - lo) : 0.f;
        u32x4 c = slot[i + H]; asm volatile("" : "+v"(c));
        const float cv[8] = {bf_lo(c.x), bf_hi(c.x), bf_lo(c.y), bf_hi(c.y), bf_lo(c.z), bf_hi(c.z), bf_lo(c.w), bf_hi(c.w)};
        float o8[8];
#pragma unroll
        for (int j = 0; j < 8; ++j) o8[j] = (t < SEQ) ? sum[j] * rc - cv[j] : 0.f;
        if constexpr (MODE == 0) {
            pm[i].x = cvt_pk_bf16(o8[0], o8[1]); pm[i].y = cvt_pk_bf16(o8[2], o8[3]); pm[i].z = cvt_pk_bf16(o8[4], o8[5]); pm[i].w = cvt_pk_bf16(o8[6], o8[7]);
        } else if constexpr (MODE == 1) {
            const bool first = (t0 + i == 0);
            const u32x4 mw = pm[7 - i];
            const float mv[8] = {bf_lo(mw.x), bf_hi(mw.x), bf_lo(mw.y), bf_hi(mw.y), bf_lo(mw.z), bf_hi(mw.z), bf_lo(mw.w), bf_hi(mw.w)};
            float ps[8], pd[8];
#pragma unroll
            for (int q = 0; q < 8; ++q) { const float a = o8[q], m = mv[q]; ps[q] = first ? a : 0.5f * (a + m); pd[q] = first ? 0.f : 0.5f * (a - m); }
            u32x4 w; w.x = cvt_pk_bf16(ps[0], ps[1]); w.y = cvt_pk_bf16(ps[2], ps[3]); w.z = cvt_pk_bf16(ps[4], ps[5]); w.w = cvt_pk_bf16(ps[6], ps[7]);
            *(u32x4*)(fs + (size_t)i * 2048) = w;
            w.x = cvt_pk_bf16(pd[0], pd[1]); w.y = cvt_pk_bf16(pd[2], pd[3]); w.z = cvt_pk_bf16(pd[4], pd[5]); w.w = cvt_pk_bf16(pd[6], pd[7]);
            *(u32x4*)(fd + (size_t)i * 2048) = w;
        } else { *(f32x4*)ny = (f32x4){o8[0], o8[1], o8[2], o8[3]}; *(f32x4*)(ny + 4) = (f32x4){o8[4], o8[5], o8[6], o8[7]}; }
        if (i < 7 && MODE != 2) { const u32x4 a = slot[i + 2 * H]; u32x4 d = slot[i]; asm volatile("" : "+v"(d));
            sum[0] += bf_lo(a.x) - bf_lo(d.x); sum[1] += bf_hi(a.x) - bf_hi(d.x); sum[2] += bf_lo(a.y) - bf_lo(d.y); sum[3] += bf_hi(a.y) - bf_hi(d.y);
            sum[4] += bf_lo(a.z) - bf_lo(d.z); sum[5] += bf_hi(a.z) - bf_hi(d.z); sum[6] += bf_lo(a.w) - bf_lo(d.w); sum[7] += bf_hi(a.w) - bf_hi(d.w); }
    }
}
template <int H>
__device__ __forceinline__ void pool_item(unsigned char* ws, int b, int c, int chunk) {
    const int t0 = chunk * 8;
    const bf16* up = (const bf16*)(ws + WS_UP) + (size_t)b * SEQ * 1024 + c;
    bf16* fs = (bf16*)(ws + WS_F) + ((size_t)b * KH + t0) * 2048 + 1024 + c; bf16* fd = fs + (size_t)NB * KH * 2048;
    float* ny = (float*)(ws + WS_NY) + (size_t)b * 2048 + 1024 + c;
    u32x4 pmr[8];
    pool_pass<H, 0>(up, SEQ - t0 - 7, pmr, fs, fd, ny, t0);
    asm volatile("" ::: "memory");
    pool_pass<H, 1>(up, t0, pmr, fs, fd, ny, t0);
    asm volatile("" ::: "memory");
    if (chunk == 255) pool_pass<H, 2>(up, 2048, pmr, fs, fd, ny, t0);
}
__device__ __forceinline__ void p_pool(Frame& F) {
    for (int it = F.wave * F.G + F.bx; it < 2048; it += F.NGW) {
        const int b = it >> 9, g = (it >> 7) & 3, chunk = 2 * (it & 127) + (F.lane >> 5), c = 256 * g + 8 * (F.lane & 31);
        switch (g) {
            case 0: pool_item<1>(F.ws, b, c, chunk); break;
            case 1: pool_item<2>(F.ws, b, c, chunk); break;
            case 2: pool_item<4>(F.ws, b, c, chunk); break;
            default: pool_item<8>(F.ws, b, c, chunk); break;
        }
    }
}

__device__ __forceinline__ void p_fft1(Frame& F) {
    constexpr float C16[16] = {1.f, 0.92387953251f, 0.70710678119f, 0.38268343236f, 0.f, -0.38268343236f, -0.70710678119f, -0.92387953251f, -1.f, -0.92387953251f, -0.70710678119f, -0.38268343236f, 0.f, 0.38268343236f, 0.70710678119f, 0.92387953251f};
    for (int it = F.bx * 512 + F.tid; it < NB * 1024 * 64; it += F.G * 512) {
        const int j4 = it & 63, bc = it >> 6, b = bc >> 10, c = bc & 1023, l2 = 4 * j4;
        const bf16* up = (const bf16*)(F.ws + WS_UT) + (size_t)bc * SEQ + l2;
        f32x4 x[16];
#pragma unroll
        for (int l1 = 0; l1 < 16; ++l1) { const u32x2 w = *(const u32x2*)(up + 256 * l1); x[l1] = (f32x4){bf_lo(w.x), bf_hi(w.x), bf_lo(w.y), bf_hi(w.y)}; }
        {
            float ny = 0.f;
#pragma unroll
            for (int l1 = 0; l1 < 16; ++l1) ny += (x[l1][0] - x[l1][1]) + (x[l1][2] - x[l1][3]);
            ny = wave_sum(ny, F.lane);
            if (F.lane == 0) ((float*)(F.ws + WS_NY))[(size_t)b * 2048 + c] = ny;
        }
        f32x4 t0[4], t1r[4], t1s[4], t2[4];
#pragma unroll
        for (int bp = 0; bp < 4; ++bp) { const f32x4 e = x[bp] + x[8 + bp], o = x[4 + bp] + x[12 + bp]; t0[bp] = e + o; t2[bp] = e - o; t1r[bp] = x[bp] - x[8 + bp]; t1s[bp] = x[4 + bp] - x[12 + bp]; }
        bf16* zp = (bf16*)(F.ws + WS_ZT) + (((size_t)(b * 9) * 1024 + c) * 2) * 256 + l2;
#pragma unroll
        for (int k1 = 0; k1 <= 8; ++k1) {
            const int q = k1 & 3;
            f32x4 yr = (f32x4){0.f, 0.f, 0.f, 0.f}, ys = yr;
#pragma unroll
            for (int bp = 0; bp < 4; ++bp) {
                const float ca = C16[(k1 * bp) & 15], sa = C16[((k1 * bp) + 12) & 15];
                const f32x4 tr = (q == 0) ? t0[bp] : (q == 2) ? t2[bp] : t1r[bp];
                if (q & 1) { const f32x4 ts = (q == 1) ? t1s[bp] : (f32x4){0.f, 0.f, 0.f, 0.f} - t1s[bp];
                    yr = yr + tr * ca - ts * sa; ys = ys + tr * sa + ts * ca; }
                else { yr = yr + tr * ca; ys = ys + tr * sa; }
            }
            u32x2 w0, w1;
            w0.x = cvt_pk_bf16(yr[0], yr[1]); w0.y = cvt_pk_bf16(yr[2], yr[3]); w1.x = cvt_pk_bf16(ys[0], ys[1]); w1.y = cvt_pk_bf16(ys[2], ys[3]);
            bf16* o = zp + (size_t)k1 * (1024 * 512);
            *(u32x2*)o = w0; *(u32x2*)(o + 256) = w1;
        }
    }
}

__device__ __forceinline__ void p_row2048(Frame& F, int l) {
    const int gwi = F.wave * F.G + F.bx;
    if (gwi >= NB * 512) return;
    const int b = gwi >> 9, n0 = (gwi & 511) * 4;
    const float* ny = (const float*)(F.ws + WS_NY) + (size_t)b * 2048 + 8 * F.lane;
    f32x4 a[4][2];
#pragma unroll
    for (int i = 0; i < 4; ++i) { a[i][0] = *(const f32x4*)(ny + 512 * i); a[i][1] = *(const f32x4*)(ny + 512 * i + 4); }
    const bf16* wrow = (const bf16*)(F.ws + WS_WO2) + ((size_t)(l * 2) * D + n0) * 2048 + 8 * F.lane;
    bf16* xb = (bf16*)(F.ws + WS_XB) + (size_t)(b * SEQ + 2048) * D + n0; unsigned char* x8 = F.ws + WS_XS + (size_t)(b * SEQ + 2048) * D + n0;
    const u32x2 xr = *(const u32x2*)xb;
    const float xres[4] = {bf_lo(xr.x), bf_hi(xr.x), bf_lo(xr.y), bf_hi(xr.y)};
    u32x4 wv[4][4];
#pragma unroll
    for (int j = 0; j < 4; ++j)
#pragma unroll
        for (int i = 0; i < 4; ++i) wv[j][i] = *(const u32x4*)(wrow + (size_t)j * 2048 + 512 * i);
    float dv[4];
#pragma unroll
    for (int j = 0; j < 4; ++j) {
        float d = 0.f;
#pragma unroll
        for (int i = 0; i < 4; ++i) { const u32x4 q = wv[j][i];
            d += (a[i][0][0] * bf_lo(q.x) + a[i][0][1] * bf_hi(q.x)) + (a[i][0][2] * bf_lo(q.y) + a[i][0][3] * bf_hi(q.y)) + (a[i][1][0] * bf_lo(q.z) + a[i][1][1] * bf_hi(q.z)) + (a[i][1][2] * bf_lo(q.w) + a[i][1][3] * bf_hi(q.w)); }
        dv[j] = wave_sum(d, F.lane);
    }
    if (F.lane == 0) {
#pragma unroll
        for (int j = 0; j < 4; ++j) { const float v = dv[j] + xres[j]; xb[j] = f2bf(v); x8[j] = (unsigned char)(pk4_fp8(v, 0.f, 0.f, 0.f) & 0xffu); }
    }
}

__device__ __forceinline__ void p_router(Frame& F, int l) {
    const int fr = F.lane & 15, fq = F.lane >> 4;
    for (int it = F.wave * F.G + F.bx; it < T / 16; it += F.NGW) {
        const int tok0 = it * 16;
        const bf16* xp = (const bf16*)(F.ws + WS_XB) + (size_t)(tok0 + fr) * D + 8 * fq;
        const bf16* wp = (const bf16*)(F.ws + WS_WR) + (size_t)l * NE * D + (size_t)fr * D + 8 * fq;
        f32x4 acc = (f32x4){0.f, 0.f, 0.f, 0.f}; float ss = 0.f;
#pragma unroll 16
        for (int ks = 0; ks < D / 32; ++ks) {
            const u32x4 xa = *(const u32x4*)(xp + 32 * ks); const u32x4 wb = *(const u32x4*)(wp + 32 * ks);
            ss += bf_lo(xa.x) * bf_lo(xa.x) + bf_hi(xa.x) * bf_hi(xa.x) + bf_lo(xa.y) * bf_lo(xa.y) + bf_hi(xa.y) * bf_hi(xa.y)
                + bf_lo(xa.z) * bf_lo(xa.z) + bf_hi(xa.z) * bf_hi(xa.z) + bf_lo(xa.w) * bf_lo(xa.w) + bf_hi(xa.w) * bf_hi(xa.w);
            acc = __builtin_amdgcn_mfma_f32_16x16x32_bf16(__builtin_bit_cast(bf16x8, wb), __builtin_bit_cast(bf16x8, xa), acc, 0, 0, 0);
        }
        ss += shx(ss, 16, F.lane); ss += shx(ss, 32, F.lane);
        const float inv = 1.f / sqrtf(ss * (1.f / D) + RMS_EPS);
        float z[4], mx;
#pragma unroll
        for (int j = 0; j < 4; ++j) z[j] = acc[j] * inv;
        mx = fmaxf(fmaxf(z[0], z[1]), fmaxf(z[2], z[3])); mx = fmaxf(mx, shx(mx, 16, F.lane)); mx = fmaxf(mx, shx(mx, 32, F.lane));
        float sm = 0.f;
#pragma unroll
        for (int j = 0; j < 4; ++j) { z[j] = __expf(z[j] - mx); sm += z[j]; }
        sm += shx(sm, 16, F.lane); sm += shx(sm, 32, F.lane);
        const float rsm = 1.f / sm;
        const int tok = tok0 + fr, b = tok >> 12, t = tok & 4095;
        float* pp = (float*)(F.ws + WS_PROB) + ((size_t)b * NE + 4 * fq) * SEQ + t;
#pragma unroll
        for (int j = 0; j < 4; ++j) pp[(size_t)j * SEQ] = z[j] * rsm;
        if (fq == 0) ((float*)(F.ws + WS_RMS2))[tok] = inv;
    }
}

__device__ __forceinline__ void p_topk(Frame& F, int l) {
    if (F.bx >= NB * NE) return;
    const int b = F.bx >> 4, e = F.bx & 15, tid = F.tid, lane = F.lane, wave = F.wave;
    LAS unsigned* red = (LAS unsigned*)F.lds;
    const float* pp = (const float*)(F.ws + WS_PROB) + ((size_t)b * NE + e) * SEQ + 8 * tid;
    unsigned key[8];
    float rv[8];
    { const float* r2p = (const float*)(F.ws + WS_RMS2) + (size_t)b * SEQ + 8 * tid; const f32x4 ra = *(const f32x4*)r2p, rb = *(const f32x4*)(r2p + 4);
      const u32x4 a = *(const u32x4*)pp, c = *(const u32x4*)(pp + 4); key[0] = a.x; key[1] = a.y; key[2] = a.z; key[3] = a.w; key[4] = c.x; key[5] = c.y; key[6] = c.z; key[7] = c.w;
      rv[0] = ra[0]; rv[1] = ra[1]; rv[2] = ra[2]; rv[3] = ra[3]; rv[4] = rb[0]; rv[5] = rb[1]; rv[6] = rb[2]; rv[7] = rb[3]; }
    unsigned thr = 0u;
    int itn = 0;
    for (int hi = 30; hi >= 0; hi -= 2, ++itn) {
        const bool pair = (hi >= 1);
        const unsigned bh = 1u << hi, bl = pair ? (1u << (hi - 1)) : 0u;
        const unsigned c10 = thr | bh, c11 = thr | bh | bl, c01 = thr | bl;
        unsigned n10 = 0, n11 = 0, n01 = 0;
#pragma unroll
        for (int j = 0; j < 8; ++j) { n10 += (unsigned)__popcll(__ballot(key[j] >= c10)); n11 += (unsigned)__popcll(__ballot(key[j] >= c11)); n01 += (unsigned)__popcll(__ballot(key[j] >= c01)); }
        LAS unsigned* slot = red + (itn & 1) * 24;
        if (lane == 0) { slot[wave] = n10; slot[8 + wave] = n11; slot[16 + wave] = n01; }
        __syncthreads();
        unsigned t10 = 0, t11 = 0, t01 = 0;
#pragma unroll
        for (int w = 0; w < 8; ++w) { t10 += slot[w]; t11 += slot[8 + w]; t01 += slot[16 + w]; }
        if (pair) thr = (t11 >= (unsigned)CAP) ? c11 : (t10 >= (unsigned)CAP) ? c10 : (t01 >= (unsigned)CAP) ? c01 : thr;
        else      thr = (t10 >= (unsigned)CAP) ? c10 : thr;
    }
    __syncthreads();
    unsigned cg = 0, ce = 0;
#pragma unroll
    for (int j = 0; j < 8; ++j) { cg += (key[j] > thr) ? 1u : 0u; ce += (key[j] == thr) ? 1u : 0u; }
    const unsigned pk = cg | (ce << 16); unsigned inc = pk;
#pragma unroll
    for (int o = 1; o < 64; o <<= 1) { const unsigned v = (unsigned)__builtin_amdgcn_ds_bpermute((lane - o) << 2, (int)inc); if (lane >= o) inc += v; }
    LAS unsigned* wtot = red + 64;
    if (lane == 63) wtot[wave] = inc;
    __syncthreads();
    unsigned base = 0, total = 0;
#pragma unroll
    for (int w = 0; w < 8; ++w) { const unsigned v = wtot[w]; if (w < wave) base += v; total += v; }
    const unsigned excl = base + inc - pk;
    unsigned pg = excl & 0xffffu, pe = excl >> 16;
    const unsigned ngt = total & 0xffffu, need_eq = (unsigned)CAP - ngt;
    unsigned* roff = (unsigned*)(F.ws + WS_ROFF) + ((size_t)l * NE + e) * ESL + b * CAP;
    float* srs = (float*)(F.ws + WS_SRS) + (size_t)e * ESL + b * CAP;
    float* sgt = (float*)(F.ws + WS_SGT) + (size_t)e * ESL + b * CAP;
    int* sel = (int*)(F.ws + WS_SEL) + ((size_t)b * SEQ + 8 * tid) * NE + e;
#pragma unroll
    for (int j = 0; j < 8; ++j) {
        int s = -1;
        if (key[j] > thr) { s = (int)pg; ++pg; }
        else if (key[j] == thr) { if (pe < need_eq) s = (int)(ngt + pe); ++pe; }
        sel[(size_t)j * NE] = s;
        if (s >= 0) { roff[s] = (unsigned)((b * SEQ + 8 * tid + j) * D); srs[s] = rv[j]; sgt[s] = __builtin_bit_cast(float, key[j]); }
    }
    __syncthreads();
}

struct RowIn { u32x4 xw[4]; u32x2 ya[4], yb[4]; int sv, e0, e1; unsigned long long rest; bool any, two; };
__device__ __forceinline__ int comb_sv(const Frame& F, int row) { const int* sel = (const int*)(F.ws + WS_SEL) + (size_t)row * NE; return (F.lane < NE) ? sel[F.lane] : -1; }
__device__ __forceinline__ void comb_load(const Frame& F, int row, int sv, RowIn& R) {
    R.sv = sv;
    const bf16* bp = (const bf16*)(F.ws + WS_XB) + (size_t)row * D + 8 * F.lane;
#pragma unroll
    for (int j = 0; j < 4; ++j) R.xw[j] = *(const u32x4*)(bp + 512 * j);
    unsigned long long m = __ballot(sv >= 0);
    R.any = (m != 0ull);
    const int e0 = R.any ? __builtin_ctzll(m) : 0; m &= m - 1;
    R.two = (m != 0ull);
    const int e1 = R.two ? __builtin_ctzll(m) : e0; if (R.two) m &= m - 1;
    R.e0 = e0; R.e1 = e1; R.rest = m;
    if (R.any) {
        const int b = row >> 12;
        const unsigned char* ybase = F.ws + WS_YS + (size_t)(b * CAP) * D + 8 * F.lane;
        const int s0 = __builtin_amdgcn_readlane(sv, e0), s1 = __builtin_amdgcn_readlane(sv, e1);
        const unsigned char* y0 = ybase + ((size_t)e0 * ESL + s0) * D; const unsigned char* y1 = ybase + ((size_t)e1 * ESL + s1) * D;
#pragma unroll
        for (int j = 0; j < 4; ++j) { R.ya[j] = *(const u32x2*)(y0 + 512 * j); R.yb[j] = *(const u32x2*)(y1 + 512 * j); }
    } else {
#pragma unroll
        for (int j = 0; j < 4; ++j) { R.ya[j] = (u32x2){0u, 0u}; R.yb[j] = (u32x2){0u, 0u}; }
    }
}
__device__ __forceinline__ void comb_proc(Frame& F, int row, const RowIn& R, bool final_out) {
    const int lane = F.lane;
    f32x4 v[4][2];
#pragma unroll
    for (int j = 0; j < 4; ++j) { const u32x4 w = R.xw[j];
        v[j][0] = (f32x4){bf_lo(w.x), bf_hi(w.x), bf_lo(w.y), bf_hi(w.y)}; v[j][1] = (f32x4){bf_lo(w.z), bf_hi(w.z), bf_lo(w.w), bf_hi(w.w)}; }
    if (R.any) {
#pragma unroll
        for (int j = 0; j < 4; ++j) add8_fp8(v[j], R.ya[j], 1.0f / YS8_SCALE);
        if (R.two) {
#pragma unroll
            for (int j = 0; j < 4; ++j) add8_fp8(v[j], R.yb[j], 1.0f / YS8_SCALE); }
    }
    const int sv = R.sv;
    unsigned long long m = R.rest;
    const int b = row >> 12;
    const unsigned char* ybase = F.ws + WS_YS + (size_t)(b * CAP) * D + 8 * lane;
    while (m) {
        const int e0 = __builtin_ctzll(m); m &= m - 1;
        const bool two = (m != 0ull);
        const int e1 = two ? __builtin_ctzll(m) : e0; if (two) m &= m - 1;
        const int s0 = __builtin_amdgcn_readlane(sv, e0), s1 = __builtin_amdgcn_readlane(sv, e1);
        const unsigned char* y0 = ybase + ((size_t)e0 * ESL + s0) * D; const unsigned char* y1 = ybase + ((size_t)e1 * ESL + s1) * D;
        u32x2 w0[4], w1[4];
#pragma unroll
        for (int j = 0; j < 4; ++j) { w0[j] = *(const u32x2*)(y0 + 512 * j); w1[j] = *(const u32x2*)(y1 + 512 * j); }
#pragma unroll
        for (int j = 0; j < 4; ++j) add8_fp8(v[j], w0[j], 1.0f / YS8_SCALE);
        if (two) {
#pragma unroll
            for (int j = 0; j < 4; ++j) add8_fp8(v[j], w1[j], 1.0f / YS8_SCALE); }
    }
    float ss = 0.f;
#pragma unroll
    for (int j = 0; j < 4; ++j)
#pragma unroll
        for (int h = 0; h < 2; ++h) ss += (v[j][h][0] * v[j][h][0] + v[j][h][1] * v[j][h][1]) + (v[j][h][2] * v[j][h][2] + v[j][h][3] * v[j][h][3]);
    const float inv = 1.f / sqrtf(wave_sum(ss, lane) * (1.f / D) + RMS_EPS);
    if (final_out) {
        float* op = F.out + (size_t)row * D + 8 * lane; const float* gp = F.gf + 8 * lane;
        f32x4 gq[4][2];
#pragma unroll
        for (int j = 0; j < 4; ++j) { gq[j][0] = *(const f32x4*)(gp + 512 * j); gq[j][1] = *(const f32x4*)(gp + 512 * j + 4); }
#pragma unroll
        for (int j = 0; j < 4; ++j)
#pragma unroll
            for (int h = 0; h < 2; ++h) *(f32x4*)(op + 512 * j + 4 * h) = v[j][h] * inv * gq[j][h];
    } else {
        bf16* bp = (bf16*)(F.ws + WS_XB) + (size_t)row * D + 8 * lane;
#pragma unroll
        for (int j = 0; j < 4; ++j) { u32x4 w; w.x = cvt_pk_bf16(v[j][0][0], v[j][0][1]); w.y = cvt_pk_bf16(v[j][0][2], v[j][0][3]); w.z = cvt_pk_bf16(v[j][1][0], v[j][1][1]); w.w = cvt_pk_bf16(v[j][1][2], v[j][1][3]);
            *(u32x4*)(bp + 512 * j) = w; }
        if (lane == 0) ((float*)(F.ws + WS_RMS1))[row] = inv;
    }
}
__device__ __forceinline__ void p_combine(Frame& F, bool final_out) {
    RowIn A, B;
    int r = F.wave * F.G + F.bx;
    int svA = (r < T) ? comb_sv(F, r) : -1;
    int svB = (r + F.NGW < T) ? comb_sv(F, r + F.NGW) : -1;
    if (r < T) comb_load(F, r, svA, A);
    while (r < T) {
        const int r2 = r + F.NGW, r3 = r2 + F.NGW, r4 = r3 + F.NGW;
        svA = (r3 < T) ? comb_sv(F, r3) : -1;
        if (r2 < T) comb_load(F, r2, svB, B);
        comb_proc(F, r, A, final_out);
        if (r2 >= T) break;
        svB = (r4 < T) ? comb_sv(F, r4) : -1;
        if (r3 < T) comb_load(F, r3, svA, A);
        comb_proc(F, r2, B, final_out);
        r = r3;
    }
}

constexpr int PPL = 8, N_PHASES = 1 + PPL * NL;
__global__ void __launch_bounds__(512, 2) fwd(Args args) {
    extern __shared__ __attribute__((aligned(16))) unsigned char lds_raw[];
    Frame F;
    F.lds = (LAS unsigned char*)lds_raw;
    F.tid = 0; F.lane = 0; F.wave = __builtin_amdgcn_readfirstlane(threadIdx.x >> 6);
    F.G = gridDim.x; F.gw = blockIdx.x * 8 + F.wave; F.NGW = F.G * 8;
    F.x = args.in[0]; F.g1 = args.in[1]; F.w_in = args.in[2]; F.w_f = args.in[3]; F.w_p = args.in[4]; F.p_s = args.in[5]; F.w_out = args.in[6];
    F.g2 = args.in[7]; F.w_r = args.in[8]; F.w_g = args.in[9]; F.w_u = args.in[10]; F.w_d = args.in[11]; F.gf = args.in[12];
    F.out = args.out; F.ws = args.ws;
    volatile LAS unsigned* misc = (volatile LAS unsigned*)(F.lds + MISC_OFF);
    if (threadIdx.x < 64) misc[threadIdx.x] = 0u;
    __syncthreads();
    unsigned* barw = (unsigned*)(F.ws + WS_CTL) + CW_BAR;
    XcdBarrier bar; bar.bar = barw; bar.x = 0; bar.st = nullptr;
    if (!MK_PER_PHASE) bar = xcd_barrier_post(barw, misc + 8);
    const int lo = args.ph_lo, hi = args.ph_hi;
#if MK_PER_PHASE
#define IN(k) (lo <= (k) && (k) < hi)
#else
#define IN(k) true
#endif
#define SEAM(k, mn_) do { if (IN(k) && IN((k) + 1)) { int wv_ = F.wave; asm volatile("" : "+s"(wv_)); const bool mem_ = xcd_barrier_arrive(bar, wv_, (unsigned)nbar); \
        if (SHADOW && mem_ && cvn >= (mn_) && cvn < 48) { LAUNDER; p_conv(Fp, cvn, cvn + 1); ++cvn; } \
        xcd_barrier_finish(bar, wv_, (unsigned)nbar); ++nbar; } } while (0)
    LAS unsigned char* ring = F.lds;
    F.bx = (int)blockIdx.x;

#define RLOOP(bit) _Pragma("nounroll") for (int rep_ = 0; rep_ < ((REP & (bit)) ? 2 : 1); ++rep_)
#define LAUNDER Frame Fp = F; { unsigned long long z_ = 0ull; asm volatile("" : "+s"(z_)); Fp.ws = F.ws + z_; }     asm volatile("" : "+s"(Fp.wave)); asm volatile("" : "+s"(Fp.bx)); Fp.gw = Fp.bx * 8 + Fp.wave; asm volatile("v_mbcnt_lo_u32_b32 %0, -1, 0\n\tv_mbcnt_hi_u32_b32 %0, -1, %0" : "=v"(Fp.lane)); Fp.tid = Fp.wave * 64 + Fp.lane
    RLOOP(1) if (IN(0)) { LAUNDER; p_prep(Fp); __syncthreads(); }
    int nbar = 0;
    int cvn = 0;
    SEAM(0, 0);
#define PHASEG(ng_, nu_, j0_, j1_, ...) { const int grp_ = (F.bx >> 3) % (ng_); const bool cv_ = cvn < (j1_); const int split_ = cv_ ? (grp_ * (nu_) * 2 + ((ng_) - 1)) / (2 * ((ng_) - 1)) : (nu_); \
    _Pragma("nounroll") for (int s_ = 0; s_ < 2; ++s_) { const int u0_ = s_ ? split_ : 0, u1_ = s_ ? (nu_) : split_; \
        if (u1_ > u0_) { __VA_ARGS__ } \
        if (s_ == 0 && cv_) { LAUNDER; p_conv(Fp, cvn, j1_); cvn = (j1_); } } }
#pragma nounroll
    for (int l = 0; l < NL; ++l) {
        const int pb = 1 + PPL * l;
        const int cW0 = l ? 28 : 0, cW1 = l ? 33 : 6, cO0 = l ? 33 : 6, cO1 = l ? 40 : 16, cF0 = l ? 40 : 16, cF1 = l ? 48 : 24, cG0 = 24, cG1 = l ? 24 : 28;
        if (l == 0) { LAUNDER; OrdFold S{Fp.ws, 0, F.G, Fp.bx}; EpiFold E{Fp.ws, 0}; pg8::gemm_phase<4, 512, false, false, false>(ring, Fp.wave, S, E); }
        PHASEG(3, 2, cW0, cW1, { LAUNDER; OrdWin S{Fp.ws, l, F.G, Fp.bx, u0_, u1_}; EpiWin E{Fp.ws}; pg8::gemm_phase<D / 64, D * 2, false, false, true>(ring, Fp.wave, S, E); })
        SEAM(pb + 0, l ? 24 : 0);
        if (l == 0) { LAUNDER; OrdFold S{Fp.ws, 1, F.G, Fp.bx}; EpiFold E{Fp.ws, 1}; pg8::gemm_phase<4, 512, false, false, false>(ring, Fp.wave, S, E); }
        { LAUNDER; p_fft1(Fp); p_pool(Fp); }
        SEAM(pb + 1, l ? 24 : 0);
        PHASEG(2, 1, 0, 0, { LAUNDER; OrdDft S{Fp.ws, F.G, Fp.bx, u0_, u1_}; EpiDft E{Fp.ws}; pg8::gemm_phase<8, 1024, false, false, false>(ring, Fp.wave, S, E); })
        SEAM(pb + 1, l ? 24 : 0);
        { LAUNDER; p_row2048(Fp, l); }
        PHASEG(3, 2, cO0, cO1, { LAUNDER; OrdWout S{Fp.ws, l, F.G, Fp.bx, u0_, u1_}; EpiSD E{Fp.ws, Fp.bx}; pg8::gemm_phase<KH / 64, KH * 2, false, false, false>(ring, Fp.wave, S, E); })
        SEAM(pb + 2, l ? 24 : 0);
        { LAUNDER; p_router(Fp, l); }
        SEAM(pb + 3, l ? 24 : 0);
        { LAUNDER; p_topk(Fp, l); }
        SEAM(pb + 4, l ? 40 : 16);
        PHASEG(8, 8, cF0, cF1, { LAUNDER; OrdFfn1 S{Fp.ws, l, F.G, Fp.bx, u0_, u1_}; EpiSwiglu E{Fp.ws}; pg8::gemm_phase<D / 128, D, true, true, true>(ring, Fp.wave, S, E, (const unsigned*)(Fp.ws + WS_ROFF) + (size_t)l * NE * ESL); })
        SEAM(pb + 5, l ? 48 : 24);
        PHASEG(5, 4, cG0, cG1, { LAUNDER; OrdFfn2 S{Fp.ws, l, F.G, Fp.bx, u0_, u1_}; EpiDown E{Fp.ws}; pg8::gemm_phase<D / 128, D, true, false, true>(ring, Fp.wave, S, E); })
        SEAM(pb + 6, l ? 48 : 24);
        { LAUNDER; p_combine(Fp, l == NL - 1); }
        if (l + 1 < NL) SEAM(pb + 7, 24);
    }
#undef PHASEG
#undef LAUNDER
#undef RLOOP
#undef IN
#undef SEAM
}

extern "C" void kernel_launch(void* const* d_in, const int* in_sizes, int n_in, void* d_out, int out_size, void* d_ws, size_t ws_size, hipStream_t stream) {
    static int grid = 0;
    if (grid == 0) {
        if (n_in != 13 || in_sizes[0] != T * D || out_size != T * D || ws_size < WS_END) {
            fprintf(stderr, "kernel_launch: unexpected shapes (n_in %d, in0 %d, out %d, ws %zu < %zu); nothing launched\n", n_in, n_in > 0 ? in_sizes[0] : -1, out_size, ws_size, (size_t)WS_END); grid = -1; return; }
        int dev = 0, cus = 0, per_cu = 0;
        if (hipGetDevice(&dev) != hipSuccess || hipDeviceGetAttribute(&cus, hipDeviceAttributeMultiprocessorCount, dev) != hipSuccess) { fprintf(stderr, "kernel_launch: device query failed\n"); grid = -1; return; }
        if (hipFuncSetAttribute((const void*)fwd, hipFuncAttributeMaxDynamicSharedMemorySize, LDS_BYTES) != hipSuccess) { fprintf(stderr, "kernel_launch: hipFuncSetAttribute failed\n"); grid = -1; return; }
        if (hipOccupancyMaxActiveBlocksPerMultiprocessor(&per_cu, (const void*)fwd, 512, LDS_BYTES) != hipSuccess || per_cu < 1) fprintf(stderr, "kernel_launch: occupancy query reports %d\n", per_cu);
        (void)hipGetLastError();
        grid = cus;
        if (grid > 256) grid = 256;
        grid &= ~7;
        if (grid != 256) fprintf(stderr, "kernel_launch: this kernel's unit maps assume 256 workgroups (one per CU of a 256-CU device); got %d\n", grid);
    }
    if (grid <= 0) return;
    (void)hipMemsetAsync((char*)d_ws + WS_CTL, 0, CTL_ZERO_BYTES, stream);
    Args a{};
    for (int i = 0; i < 13; ++i) a.in[i] = (const float*)d_in[i];
    a.out = (float*)d_out; a.ws = (unsigned char*)d_ws;
#if MK_PER_PHASE
    for (int p = 0; p < N_PHASES; ++p) { a.ph_lo = p; a.ph_hi = p + 1; hipLaunchKernelGGL(fwd, dim3(grid), dim3(512), LDS_BYTES, stream, a); }
#else
    a.ph_lo = 0; a.ph_hi = N_PHASES;
    hipLaunchKernelGGL(fwd, dim3(grid), dim3(512), LDS_BYTES, stream, a);
#endif
    const hipError_t le = hipPeekAtLastError();
    if (le != hipSuccess) fprintf(stderr, "kernel_launch: launch failed: %s\n", hipGetErrorName(le));
}
```

```cpp
#include <hip/hip_runtime.h>
#include <cstdio>
#include <cstdint>

#ifndef SHADOW
#define SHADOW 1
#endif
#ifndef REP
#define REP 0
#endif
#ifndef MK_PER_PHASE
#define MK_PER_PHASE 0
#endif

#define GAS __attribute__((address_space(1)))
#define LAS __attribute__((address_space(3)))
#define CAS __attribute__((address_space(4)))
typedef unsigned short bf16;
typedef short bf16x8 __attribute__((ext_vector_type(8)));
typedef float f32x4 __attribute__((ext_vector_type(4)));
typedef unsigned u32x4 __attribute__((ext_vector_type(4)));
typedef unsigned u32x2 __attribute__((ext_vector_type(2)));
typedef float f32x2 __attribute__((ext_vector_type(2)));

constexpr int NB = 4, SEQ = 4096, D = 2048, T = NB * SEQ, NL = 2, NE = 16, CAP = 512, ESL = NB * CAP  ;
constexpr int KH = 2048;
constexpr float RMS_EPS = 1e-6f;

constexpr size_t MiB = 1u << 20;
constexpr size_t WS_CTL = 0, CTL_ZERO_BYTES = 64 * 1024;
constexpr size_t WS_RMS1 = 1 * MiB;
constexpr size_t WS_RMS2 = WS_RMS1 + 64 * 1024;
constexpr size_t WS_WR   = WS_RMS2 + 64 * 1024;
constexpr size_t WS_CCS  = WS_WR + 128 * 1024;
constexpr size_t WS_SRS  = WS_CCS + 256 * 1024;
constexpr size_t WS_SGT  = WS_SRS + 128 * 1024;
constexpr size_t WS_ROFF = WS_SGT + 128 * 1024;
constexpr size_t WS_PROB = 2 * MiB;
constexpr size_t WS_SEL  = 3 * MiB;
constexpr size_t WS_WF   = 4 * MiB;
constexpr size_t WS_WPS  = 5 * MiB;
constexpr size_t WS_TT   = 6 * MiB;
constexpr size_t WS_WIN  = 16 * MiB;
constexpr size_t WS_WOT  = 32 * MiB;
constexpr size_t WS_WO2  = 48 * MiB;
constexpr size_t WS_NY   = 14 * MiB;
constexpr size_t WS_SS   = 264 * MiB;
constexpr size_t WS_CS   = 80 * MiB;
constexpr size_t WS_ZT   = 200 * MiB;
constexpr size_t WS_XB   = 136 * MiB;
constexpr size_t WS_UT   = 328 * MiB;
constexpr size_t WS_UP   = 360 * MiB;
constexpr size_t WS_F    = 392 * MiB;
constexpr size_t WS_HID  = 488 * MiB;
constexpr size_t WS_YS   = 616 * MiB;
constexpr size_t WS_XS   = 552 * MiB;
constexpr size_t WS_WGU  = 744 * MiB;
constexpr size_t WS_WD   = 1256 * MiB;
constexpr size_t WS_END  = 1512 * MiB;
constexpr int CW_BAR = 1024;

constexpr int RING_BYTES = 131072, MISC_OFF = RING_BYTES, GTAB_OFF = RING_BYTES + 1024, SCT_OFF = GTAB_OFF + 16384, LDS_BYTES = SCT_OFF + 3072;

__device__ __forceinline__ unsigned cvt_pk_bf16(float lo, float hi) { unsigned r; asm volatile("v_cvt_pk_bf16_f32 %0, %1, %2" : "=v"(r) : "v"(lo), "v"(hi)); return r; }
__device__ __forceinline__ float bf_lo(unsigned w) { return __builtin_bit_cast(float, w << 16); }
__device__ __forceinline__ float bf_hi(unsigned w) { return __builtin_bit_cast(float, w & 0xffff0000u); }
constexpr float W8_SCALE = 64.f, H8_SCALE = 8.f, YS8_SCALE = 64.f;
__device__ __forceinline__ unsigned pk4_fp8(float a, float b, float c, float d) { int w = __builtin_amdgcn_cvt_pk_fp8_f32(a, b, 0, false); w = __builtin_amdgcn_cvt_pk_fp8_f32(c, d, w, true); return (unsigned)w; }
__device__ __forceinline__ float shx(float v, int o, int lane) { return __builtin_bit_cast(float, __builtin_amdgcn_ds_bpermute((lane ^ o) << 2, __builtin_bit_cast(int, v))); }
__device__ __forceinline__ unsigned shxu(unsigned v, int o, int lane) { return (unsigned)__builtin_amdgcn_ds_bpermute((lane ^ o) << 2, (int)v); }
__device__ __forceinline__ float wave_sum(float v, int lane) {
#pragma unroll
    for (int o = 1; o < 64; o <<= 1) v += shx(v, o, lane);
    return v;
}
#define LDS_WAIT() asm volatile("s_waitcnt lgkmcnt(0)" ::: "memory")
#define VM_WAIT() asm volatile("s_waitcnt vmcnt(0)" ::: "memory")

#define XB_TMO      128
#define XB_XCNT(j)  (256  + 64 * (j))
#define XB_XSUB(j)  (1280 + 64 * (j))
#define XB_XGEN(j)  (2304 + 64 * (j))
#define XB_TOP      3328
#define XB_TOPGEN   3392
#define XCD_BAR_WORDS 3456
#define XB_SPIN_CAP (1u << 18)
__device__ __forceinline__ unsigned xb_ld(unsigned* p)              { return __hip_atomic_load(p, __ATOMIC_RELAXED, __HIP_MEMORY_SCOPE_AGENT); }
__device__ __forceinline__ unsigned xb_add(unsigned* p, unsigned v) { return __hip_atomic_fetch_add(p, v, __ATOMIC_RELAXED, __HIP_MEMORY_SCOPE_AGENT); }
__device__ __forceinline__ unsigned xb_xcc_id() { return (unsigned)__builtin_amdgcn_s_getreg((3 << 11) | 20) & 0xFu; }
#define XB_SPIN(cond, bar) do { unsigned _sp = 0; while (cond) { __builtin_amdgcn_s_sleep(1); \
    if ((++_sp & 255u) == 0u) { if (xb_ld(&(bar)[XB_TMO])) break; if (_sp > XB_SPIN_CAP) { atomicAdd(&(bar)[XB_TMO], 1u); break; } } } } while (0)
struct XcdBarrier { unsigned* bar; unsigned x; volatile LAS unsigned* st; };
__device__ __forceinline__ XcdBarrier xcd_barrier_post(unsigned* bar, volatile LAS unsigned* st) {
    XcdBarrier b; b.bar = bar; b.x = xb_xcc_id(); b.st = st;
    if (threadIdx.x == 0) st[2] = xb_add(&bar[XB_XCNT(b.x)], 1u);
    return b;
}
__device__ __forceinline__ void xcd_barrier_complete(unsigned* bar, unsigned x, unsigned& nloc, unsigned& nx) {
    const unsigned G = gridDim.x * gridDim.y * gridDim.z;
    unsigned sum, cnt, mine, sp = 0u;
    for (;;) {
        sum = 0u; cnt = 0u; mine = 0u;
#pragma unroll
        for (unsigned j = 0; j < 16; ++j) { const unsigned c = xb_ld(&bar[XB_XCNT(j)]); sum += c; cnt += (c > 0u) ? 1u : 0u; mine = (j == x) ? c : mine; }
        if (sum == G) break;
        __builtin_amdgcn_s_sleep(1);
        if ((++sp & 255u) == 0u) { if (xb_ld(&bar[XB_TMO])) break; if (sp > XB_SPIN_CAP) { atomicAdd(&bar[XB_TMO], 1u); break; } }
    }
    nloc = mine > 0u ? mine : 1u; nx = cnt > 0u ? cnt : 1u;
}
__device__ __forceinline__ void xcd_barrier(const XcdBarrier& b, const int wave_id) {
    asm volatile("s_waitcnt vmcnt(0)" ::: "memory");
    __syncthreads();
    int ln_; asm volatile("v_mbcnt_lo_u32_b32 %0, -1, 0\n\tv_mbcnt_hi_u32_b32 %0, -1, %0" : "=v"(ln_));
    if (wave_id == 0 && ln_ == 0) {
        unsigned* bar = b.bar; unsigned bx = b.x;
        asm volatile("" : "+s"(bar), "+s"(bx));
        __builtin_amdgcn_s_waitcnt(0);
        unsigned nloc = b.st[0], nx = b.st[1];
        if (nloc == 0u) { xcd_barrier_complete(bar, bx, nloc, nx); b.st[0] = nloc; b.st[1] = nx; }
        const unsigned old = xb_add(&bar[XB_XSUB(bx)], 1u);
        const unsigned gen = old / nloc;
        if (old + 1u == (gen + 1u) * nloc) {
            __builtin_amdgcn_fence(__ATOMIC_RELEASE, "agent");
            asm volatile("s_waitcnt vmcnt(0)" ::: "memory");
            const unsigned og = xb_add(&bar[XB_TOP], 1u);
            const unsigned tg = og / nx;
            if (og + 1u == (tg + 1u) * nx) xb_add(&bar[XB_TOPGEN], 1u);
            else XB_SPIN(xb_ld(&bar[XB_TOPGEN]) == tg, bar);
            __builtin_amdgcn_fence(__ATOMIC_ACQUIRE, "agent");
            xb_add(&bar[XB_XGEN(bx)], 1u);
            asm volatile("s_waitcnt vmcnt(0)" ::: "memory");
        } else {
            XB_SPIN(xb_ld(&bar[XB_XGEN(bx)]) == gen, bar);
            __builtin_amdgcn_fence(__ATOMIC_ACQUIRE, "agent");
            asm volatile("s_waitcnt vmcnt(0)" ::: "memory");
        }
    }
    __syncthreads();
}

__device__ __forceinline__ bool xcd_barrier_arrive(const XcdBarrier& b, const int wave_id, const unsigned nbar) {
    asm volatile("s_waitcnt vmcnt(0)" ::: "memory");
    __syncthreads();
    int ln_; asm volatile("v_mbcnt_lo_u32_b32 %0, -1, 0\n\tv_mbcnt_hi_u32_b32 %0, -1, %0" : "=v"(ln_));
    if (wave_id == 0 && ln_ == 0) {
        unsigned* bar = b.bar; unsigned bx = b.x;
        asm volatile("" : "+s"(bar), "+s"(bx));
        __builtin_amdgcn_s_waitcnt(0);
        unsigned nloc = b.st[0], nx = b.st[1];
        if (nloc == 0u) { xcd_barrier_complete(bar, bx, nloc, nx); b.st[0] = nloc; b.st[1] = nx; }
        (void)xb_add(&bar[XB_XSUB(bx)], 1u);
        b.st[3] = nbar;
    }
    __syncthreads();
    const unsigned nloc = (unsigned)__builtin_amdgcn_readfirstlane((int)b.st[0]), rank = (unsigned)__builtin_amdgcn_readfirstlane((int)b.st[2]);
    return rank != nbar % nloc;
}
__device__ __forceinline__ void xcd_barrier_finish(const XcdBarrier& b, const int wave_id, const unsigned nbar) {
    __syncthreads();
    int ln_; asm volatile("v_mbcnt_lo_u32_b32 %0, -1, 0\n\tv_mbcnt_hi_u32_b32 %0, -1, %0" : "=v"(ln_));
    if (wave_id == 0 && ln_ == 0) {
        unsigned* bar = b.bar; unsigned bx = b.x;
        asm volatile("" : "+s"(bar), "+s"(bx));
        const unsigned nloc = b.st[0], nx = b.st[1], gen = nbar;
        if (b.st[2] == gen % nloc) {
            XB_SPIN(xb_ld(&bar[XB_XSUB(bx)]) < (gen + 1u) * nloc, bar);
            __builtin_amdgcn_fence(__ATOMIC_RELEASE, "agent");
            asm volatile("s_waitcnt vmcnt(0)" ::: "memory");
            const unsigned og = xb_add(&bar[XB_TOP], 1u);
            const unsigned tg = og / nx;
            if (og + 1u == (tg + 1u) * nx) xb_add(&bar[XB_TOPGEN], 1u);
            else XB_SPIN(xb_ld(&bar[XB_TOPGEN]) == tg, bar);
            __builtin_amdgcn_fence(__ATOMIC_ACQUIRE, "agent");
            xb_add(&bar[XB_XGEN(bx)], 1u);
            asm volatile("s_waitcnt vmcnt(0)" ::: "memory");
        } else {
            XB_SPIN(xb_ld(&bar[XB_XGEN(bx)]) == gen, bar);
            __builtin_amdgcn_fence(__ATOMIC_ACQUIRE, "agent");
            asm volatile("s_waitcnt vmcnt(0)" ::: "memory");
        }
    }
    __syncthreads();
}

namespace pg8 {
constexpr int BM = 256, BK = 64, HALF = 128, HTB = HALF * BK * 2, STAGE_BYTES = 8 * HTB;
__device__ __forceinline__ int lds_byte(int r, int c) { const int st = (r >> 4) * 2 + (c >> 5), rr = r & 15, cc = c & 31, ob = rr * 64 + cc * 2; return st * 1024 + (ob ^ (((ob >> 9) & 1) << 5)); }
__device__ __forceinline__ void stage_rc(int b, int& R, int& C) { const int st = b / 1024, sb = b % 1024, swz = sb ^ (((sb >> 9) & 1) << 5); R = (st >> 1) * 16 + swz / 64; C = (st & 1) * 32 + (swz % 64) / 2; }
__device__ __forceinline__ int perm32(int rho) { const int n = rho >> 4, i = rho & 15; return 8 * (i >> 2) + 4 * n + (i & 3); }

typedef int i32x8 __attribute__((ext_vector_type(8)));
typedef double f64x2z __attribute__((ext_vector_type(2)));
typedef int i32x4 __attribute__((ext_vector_type(4)));
__device__ __forceinline__ i32x8 cat8(bf16x8 lo, bf16x8 hi) { const i32x4 a = __builtin_bit_cast(i32x4, lo), b = __builtin_bit_cast(i32x4, hi); return __builtin_shufflevector(a, b, 0, 1, 2, 3, 4, 5, 6, 7); }
struct Unit { const char* a; const char* b; int pm, pn; };

template <int NT  , int PITCH  , bool FP8  , bool GATHER, bool SCL  , class Epi, class Sched>
__device__ __forceinline__ void gemm_phase(LAS unsigned char* lds, const int wave_id, const Sched& S, const Epi& E, const unsigned* gro = nullptr) {
    int lane_; asm volatile("v_mbcnt_lo_u32_b32 %0, -1, 0\n\tv_mbcnt_hi_u32_b32 %0, -1, %0" : "=v"(lane_)); const int tid_ = wave_id * 64 + lane_;
    const int tid = tid_, wid = wave_id, lane = lane_, wr = wid >> 2, wc = wid & 3, fr = lane & 15, fq = lane >> 4;
    constexpr int nt = NT;
    static_assert(NT % 2 == 0 && NT >= 4, "K");
    unsigned voffA[2], voffB[2];
#pragma unroll
    for (int i = 0; i < 2; ++i) { int R, C; stage_rc(tid * 16 + i * 8192, R, C); const int Rb = (R & ~31) + perm32(R & 31);
        voffA[i] = GATHER ? (unsigned)(C * 2) : (unsigned)(R * PITCH + C * 2); voffB[i] = (unsigned)(Rb * PITCH + C * 2); }
    const unsigned gtab = (unsigned)(size_t)lds + (unsigned)STAGE_BYTES + 1024u;
    constexpr size_t kstep = (size_t)(BK * 2);
    constexpr size_t hstep = (size_t)HALF * PITCH;
    const unsigned ldsb = (unsigned)(size_t)lds + (unsigned)wid * 1024u;
    const int aoff = lds_byte(wr * 64 + fr, fq * 8), boff = lds_byte(wc * 32 + fr, fq * 8);
#define PG8_SA(b, h) (((b) * 2 + (h)) * HTB)
#define PG8_SB(b, h) ((4 + (b) * 2 + (h)) * HTB)
#define PG8_DMA16(voff_, sbase_, ldsdst_) do { unsigned _keep; asm volatile("s_mov_b32 m0, %2\n\ts_nop 0\n\tglobal_load_lds_dwordx4 %0, %1" :: "v"(voff_), "s"((const char*)(sbase_)), "s"(ldsdst_) : "memory", "m0"); (void)_keep; } while (0)
#define PG8_STAGE(bufoff, gbase, voff) do { _Pragma("unroll") for (int _i = 0; _i < 2; ++_i) PG8_DMA16((voff)[_i], gbase, ldsb + (unsigned)((bufoff) + _i * 8192)); } while (0)
#define PG8_STAGE_A(bufoff, gbase_, h_, tb_) do { if constexpr (GATHER) { _Pragma("unroll") for (int _i = 0; _i < 2; ++_i) { \
            const unsigned _o = *(const LAS unsigned*)(size_t)(gtab + (unsigned)(tb_) * 8192u + (unsigned)(((h_) * 2 + _i) * 2048) + (unsigned)tid * 4u) + voffA[0]; \
            PG8_DMA16(_o, gbase_, ldsb + (unsigned)((bufoff) + _i * 8192)); } } \
        else { PG8_STAGE(bufoff, (gbase_) + (h_) * hstep, voffA); } } while (0)
#define PG8_GFILL(tb_, ro_) do { _Pragma("unroll") for (int _h = 0; _h < 2; ++_h) _Pragma("unroll") for (int _i = 0; _i < 2; ++_i) { unsigned _keep; \
        asm volatile("s_mov_b32 m0, %2\n\ts_nop 0\n\tglobal_load_lds_dword %0, %1" :: "v"((unsigned)(lane & ~3)), "s"((const char*)(ro_) + _h * 512 + 64 * ((wid + 8 * _i) >> 1)), \
                     "s"(gtab + (unsigned)(tb_) * 8192u + (unsigned)((_h * 2 + _i) * 2048) + (unsigned)wid * 256u) : "memory", "m0"); (void)_keep; } } while (0)
#define PG8_SCFILL(buf_, ptr_) do { if (wid < 4) { unsigned _keep; const char* _p = (const char*)(ptr_) + wid * 256; \
        const unsigned _lo = (unsigned)__builtin_amdgcn_readfirstlane((int)(unsigned)(size_t)_p), _hi = (unsigned)__builtin_amdgcn_readfirstlane((int)(unsigned)((size_t)_p >> 32)); \
        const char* _ps = (const char*)(((size_t)_hi << 32) | (size_t)_lo); \
        asm volatile("s_mov_b32 m0, %2\n\ts_nop 0\n\tglobal_load_lds_dword %0, %1" :: "v"((unsigned)(lane * 4)), "s"(_ps), \
                     "s"((unsigned)(size_t)lds + (unsigned)(STAGE_BYTES + 1024 + 16384) + (unsigned)(buf_) * 1024u + (unsigned)wid * 256u) : "memory", "m0"); (void)_keep; } } while (0)
#define PG8_LDA(dst, b, h) do { _Pragma("unroll") for (int m = 0; m < 4; ++m) _Pragma("unroll") for (int k = 0; k < 2; ++k) dst[m][k] = *(const LAS bf16x8*)(lds + PG8_SA(b, h) + aoff + m * 2048 + k * 1024); } while (0)
#define PG8_LDB(dst, b, h) do { _Pragma("unroll") for (int n = 0; n < 2; ++n) _Pragma("unroll") for (int k = 0; k < 2; ++k) dst[n][k] = *(const LAS bf16x8*)(lds + PG8_SB(b, h) + boff + n * 2048 + k * 1024); } while (0)
#define PG8_MMA(ai, bj, At, Bt) do { __builtin_amdgcn_s_setprio(1); _Pragma("unroll") for (int m = 0; m < 4; ++m) _Pragma("unroll") for (int n = 0; n < 2; ++n) { \
        if constexpr (FP8) acc[ai][bj][m][n] = __builtin_amdgcn_mfma_scale_f32_16x16x128_f8f6f4(cat8(Bt[n][0], Bt[n][1]), cat8(At[m][0], At[m][1]), acc[ai][bj][m][n], 0, 0, 0, 0, 0, 0);     \
        else { _Pragma("unroll") for (int k = 0; k < 2; ++k) acc[ai][bj][m][n] = __builtin_amdgcn_mfma_f32_16x16x32_bf16(Bt[n][k], At[m][k], acc[ai][bj][m][n], 0, 0, 0); } } __builtin_amdgcn_s_setprio(0); } while (0)
#define PG8_WAIT_V(n) asm volatile("s_waitcnt vmcnt(" #n ")" ::: "memory")
#define PG8_WAIT_L(n) asm volatile("s_waitcnt lgkmcnt(" #n ")" ::: "memory")
#define PG8_BAR __builtin_amdgcn_s_barrier()
#define PG8_SCHED __builtin_amdgcn_sched_barrier(0)
    Unit cur, nxt; int ui = 0;
    if (!S.next(0, cur)) return;
    LAS float* const sctab = (LAS float*)(lds + STAGE_BYTES + 1024 + 16384);
    int sb = 0;
    if constexpr (SCL) { PG8_SCFILL(0, E.scales(cur)); }
    f32x4 acc[2][2][4][2];
#pragma unroll
    for (int a = 0; a < 2; ++a)
#pragma unroll
        for (int b = 0; b < 2; ++b)
#pragma unroll
            for (int m = 0; m < 4; ++m)
#pragma unroll
                for (int n = 0; n < 2; ++n) { double z0_, z1_; asm volatile("v_mov_b64 %0, 0\n\tv_mov_b64 %1, 0" : "=v"(z0_), "=v"(z1_)); acc[a][b][m][n] = __builtin_bit_cast(f32x4, (f64x2z){z0_, z1_}); }
    bf16x8 At[4][2], B0[2][2], B1[2][2];
    const char* cA = cur.a; const char* cB = cur.b;
    if constexpr (GATHER) { const int pm0 = __builtin_amdgcn_readfirstlane(cur.pm); PG8_GFILL(0, gro + 256 * pm0); }
    PG8_STAGE(PG8_SB(0, 0), cB, voffB); PG8_STAGE(PG8_SB(0, 1), cB + hstep, voffB);
    if constexpr (GATHER) PG8_WAIT_V(4);
    PG8_STAGE_A(PG8_SA(0, 0), cA, 0, 0); PG8_STAGE_A(PG8_SA(0, 1), cA, 1, 0);
    if (wr == 1) PG8_BAR;
    PG8_WAIT_V(2); PG8_BAR;
    PG8_STAGE(PG8_SB(1, 0), cB + kstep, voffB); PG8_STAGE_A(PG8_SA(1, 0), cA + kstep, 0, 0); PG8_STAGE(PG8_SB(1, 1), cB + hstep + kstep, voffB);
    PG8_WAIT_V(6); PG8_BAR;
    for (;;) {
        const bool has_next = S.next(ui + 1, nxt);
        const int sbn = (sb == 2) ? 0 : sb + 1;
        if constexpr (SCL) { if (has_next) PG8_SCFILL(sbn, E.scales(nxt)); }
        const char* nA = has_next ? nxt.a : cA + (size_t)(nt - 2) * kstep; const char* nB = has_next ? nxt.b : cB + (size_t)(nt - 2) * kstep;
        const int tbc = ui & 1, tbn = has_next ? (tbc ^ 1) : tbc;
        if constexpr (GATHER) { if (has_next) PG8_GFILL(tbn, gro + 256 * nxt.pm); }
        for (int t = 0; t < nt; t += 2) {
            const bool last = (t == nt - 2);
            const char* a1 = cA + (size_t)(t + 1) * kstep;
            const char* a2 = last ? nA : cA + (size_t)(t + 2) * kstep; const char* b2 = last ? nB : cB + (size_t)(t + 2) * kstep;
            const char* a3 = a2 + kstep; const char* b3 = b2 + kstep;
            const int tb2 = last ? tbn : tbc;
            PG8_LDB(B0, 0, 0); PG8_LDB(B1, 0, 1); PG8_SCHED; PG8_LDA(At, 0, 0); PG8_STAGE_A(PG8_SA(1, 1), a1, 1, tbc);
            PG8_WAIT_V(8); PG8_WAIT_L(0); PG8_BAR; PG8_MMA(0, 0, At, B0); PG8_MMA(0, 1, At, B1); PG8_BAR; PG8_SCHED;
            PG8_LDA(At, 0, 1); PG8_STAGE(PG8_SB(0, 0), b2, voffB); PG8_STAGE(PG8_SB(0, 1), b2 + hstep, voffB); PG8_STAGE_A(PG8_SA(0, 0), a2, 0, tb2);
            PG8_WAIT_V(8); PG8_WAIT_L(0); PG8_BAR; PG8_MMA(1, 0, At, B0); PG8_MMA(1, 1, At, B1); PG8_BAR; PG8_SCHED;
            PG8_LDB(B0, 1, 0); PG8_LDB(B1, 1, 1); PG8_SCHED; PG8_LDA(At, 1, 0); PG8_STAGE_A(PG8_SA(0, 1), a2, 1, tb2);
            PG8_WAIT_V(8); PG8_WAIT_L(0); PG8_BAR; PG8_MMA(0, 0, At, B0); PG8_MMA(0, 1, At, B1); PG8_BAR; PG8_SCHED;
            PG8_LDA(At, 1, 1); PG8_STAGE(PG8_SB(1, 0), b3, voffB); PG8_STAGE(PG8_SB(1, 1), b3 + hstep, voffB); PG8_STAGE_A(PG8_SA(1, 0), a3, 0, tb2);
            PG8_WAIT_V(8); PG8_WAIT_L(0); PG8_BAR; PG8_MMA(1, 0, At, B0); PG8_MMA(1, 1, At, B1); PG8_BAR; PG8_SCHED;
        }
        if (wr == 0) PG8_BAR;
        { int le_; asm volatile("v_mbcnt_lo_u32_b32 %0, -1, 0\n\tv_mbcnt_hi_u32_b32 %0, -1, %0" : "=v"(le_)); E(acc, cur, wr, wc, le_ & 15, le_ >> 4, (const LAS float*)(sctab + sb * 256)); }
        if (!has_next) break;
#pragma unroll
        for (int a = 0; a < 2; ++a)
#pragma unroll
            for (int b = 0; b < 2; ++b)
#pragma unroll
                for (int m = 0; m < 4; ++m)
#pragma unroll
                    for (int n = 0; n < 2; ++n) { double z0_, z1_; asm volatile("v_mov_b64 %0, 0\n\tv_mov_b64 %1, 0" : "=v"(z0_), "=v"(z1_)); acc[a][b][m][n] = __builtin_bit_cast(f32x4, (f64x2z){z0_, z1_}); }
        cur = nxt; cA = nA; cB = nB; ++ui; sb = sbn;
        if (wr == 1) PG8_BAR;
    }
    PG8_WAIT_V(0);
    PG8_BAR;
#undef PG8_SA
#undef PG8_SB
#undef PG8_STAGE
#undef PG8_STAGE_A
#undef PG8_DMA16
#undef PG8_GFILL
#undef PG8_SCFILL
#undef PG8_LDA
#undef PG8_LDB
#undef PG8_MMA
#undef PG8_WAIT_V
#undef PG8_WAIT_L
#undef PG8_BAR
#undef PG8_SCHED
}

__device__ __forceinline__ void tile_of(int L, int n, int nN, int& pm, int& pn) {
    const int q = n >> 3, w = (L & 7) * q + (L >> 3);
    const int nig = 8 * nN, gid = w / nig, rem = w % nig;
    pm = gid * 8 + (rem & 7); pn = rem >> 3;
}

__device__ __forceinline__ f32x4 ld4s(const float* p) { return *(const f32x4*)p; }
__device__ __forceinline__ f32x4 ld4s(const LAS float* p) { return *(const LAS f32x4*)p; }
template <class T> struct IdT { typedef T type; };
template <bool ROWS, bool COLS, class SP = const float*>
__device__ __forceinline__ void store_tile_bf16(const f32x4 (&acc)[2][2][4][2], bf16* base, int ldc, typename IdT<SP>::type rowscale, typename IdT<SP>::type colscale, int wr, int wc, int fr, int fq, const float gscale = 1.f) {
    const int row0 = wr * 64 + fr, col0 = wc * 32 + 8 * fq;
    f32x4 cs[2][2];
#pragma unroll
    for (int bj = 0; bj < 2; ++bj)
#pragma unroll
        for (int n = 0; n < 2; ++n) cs[bj][n] = COLS ? ld4s(colscale + col0 + bj * HALF + 4 * n) : (f32x4){1.f, 1.f, 1.f, 1.f};
#pragma unroll
    for (int ai = 0; ai < 2; ++ai)
#pragma unroll
        for (int m = 0; m < 4; ++m) {
            const int r = row0 + ai * HALF + m * 16;
            const float rs = ROWS ? rowscale[r] * gscale : 1.f;
            bf16* rowp = base + (size_t)r * ldc + col0;
#pragma unroll
            for (int bj = 0; bj < 2; ++bj) {
                f32x4 v0 = acc[ai][bj][m][0], v1 = acc[ai][bj][m][1];
                if (COLS) { v0 = v0 * cs[bj][0]; v1 = v1 * cs[bj][1]; }
                if (ROWS) { v0 = v0 * rs; v1 = v1 * rs; }
                u32x4 w; w.x = cvt_pk_bf16(v0[0], v0[1]); w.y = cvt_pk_bf16(v0[2], v0[3]); w.z = cvt_pk_bf16(v1[0], v1[1]); w.w = cvt_pk_bf16(v1[2], v1[3]);
                *(u32x4*)(rowp + bj * HALF) = w; } }
}
}
using pg8::Unit;
typedef const f32x4 (&AccRef)[2][2][4][2];

struct Args { const float* in[13]; float* out; unsigned char* ws; int ph_lo, ph_hi; };
struct Frame {
    LAS unsigned char* lds; int tid, lane, wave, G, gw, NGW, bx;
    const float *x, *g1, *w_in, *w_f, *w_p, *p_s, *w_out, *g2, *w_r, *w_g, *w_u, *w_d, *gf;
    float* out; unsigned char* ws;
};

struct OrdFold {
    unsigned char* ws; int stage, G, c;
    __device__ __forceinline__ bool next(int i, Unit& u) const {
        const int L = i * G + c; if (L >= 128) return false;
        const int l = L >> 6, r = L & 63, mt = r & 7, q = r >> 3;
        u.pm = L; u.pn = 0;
        if (stage == 0) {
            const int g = q & 3;
            u.a = (const char*)((const bf16*)(ws + WS_WOT) + ((size_t)(l * 8 + q) * D + 256 * mt) * 256);
            u.b = (const char*)((const bf16*)(ws + (q < 4 ? WS_WF : WS_WPS)) + (size_t)(l * 4 + g) * 65536);
        } else {
            const int g = q >> 1, nt = q & 1;
            u.a = (const char*)((const bf16*)(ws + WS_TT) + ((size_t)(l * 4 + g) * D + 256 * mt) * 256);
            u.b = (const char*)((const bf16*)(ws + WS_CCS) + (size_t)nt * 65536);
        }
        return true;
    }
};
struct EpiFold {
    unsigned char* ws; int stage;
    __device__ __forceinline__ const float* scales(const Unit&) const { return nullptr; }
    __device__ __forceinline__ void operator()(AccRef acc, const Unit& u, int wr, int wc, int fr, int fq, const LAS float* sc) const {
        const int L = u.pm, l = L >> 6, r = L & 63, mt = r & 7, q = r >> 3;
        bf16* wo2 = (bf16*)(ws + WS_WO2) + ((size_t)(l * 2) * D + 256 * mt) * 2048;
        if (stage == 0) { const int g = q & 3;
            if (q < 4) pg8::store_tile_bf16<false, false>(acc, (bf16*)(ws + WS_TT) + ((size_t)(l * 4 + g) * D + 256 * mt) * 256, 256, nullptr, nullptr, wr, wc, fr, fq);
            else { pg8::store_tile_bf16<false, false>(acc, wo2 + 1024 + 256 * g, 2048, nullptr, nullptr, wr, wc, fr, fq);
                   pg8::store_tile_bf16<false, false>(acc, wo2 + (size_t)D * 2048 + 1024 + 256 * g, 2048, nullptr, nullptr, wr, wc, fr, fq); } }
        else { const int g = q >> 1, nt = q & 1; pg8::store_tile_bf16<false, false>(acc, wo2 + (size_t)nt * D * 2048 + 256 * g, 2048, nullptr, nullptr, wr, wc, fr, fq); }
    }
};
struct OrdWin {
    unsigned char* ws; int l, G, c, u0, u1;
    __device__ __forceinline__ bool next(int i, Unit& u) const {
        i += u0; if (i >= u1) return false;
        const int L = i * G + c; if (L >= 512) return false;
        pg8::tile_of(L, 512, 8, u.pm, u.pn);
        const char* xb = (const char*)((const bf16*)(ws + WS_XB) + (size_t)(256 * u.pm) * D);
        const char* w = (const char*)((const bf16*)(ws + WS_WIN) + (size_t)l * D * D + (size_t)(256 * u.pn) * D);
        if (u.pn < 4) { u.a = w; u.b = xb; } else { u.a = xb; u.b = w; }
        return true;
    }
};
struct EpiWin {
    unsigned char* ws;
    __device__ __forceinline__ const float* scales(const Unit& u) const { return (const float*)(ws + WS_RMS1) + 256 * u.pm; }
    __device__ __forceinline__ void operator()(AccRef acc, const Unit& u, int wr, int wc, int fr, int fq, const LAS float* sc) const {
        if (u.pn < 4) { const int b = u.pm >> 4, l0 = (u.pm & 15) * 256;
            pg8::store_tile_bf16<false, true, const LAS float*>(acc, (bf16*)(ws + WS_UT) + ((size_t)(b * 1024 + 256 * u.pn)) * SEQ + l0, SEQ, nullptr, sc, wr, wc, fr, fq); }
        else pg8::store_tile_bf16<true, false, const LAS float*>(acc, (bf16*)(ws + WS_UP) + (size_t)(256 * u.pm) * 1024 + 256 * (u.pn - 4), 1024, sc, nullptr, wr, wc, fr, fq);
    }
};
struct OrdDft {
    unsigned char* ws; int G, c, u0, u1;
    __device__ __forceinline__ bool next(int i, Unit& u) const {
        i += u0; if (i >= u1) return false;
        const int L = i * G + c; if (L >= 256) return false;
        u.pm = L >> 2; u.pn = L & 3;
        const int b = u.pm >> 4, k1 = u.pm & 15, ksrc = (k1 <= 8) ? k1 : 16 - k1;
        u.a = (const char*)(ws + WS_CS) + (size_t)k1 * (256 * 512 * 2);
        u.b = (const char*)(ws + WS_ZT) + ((size_t)(b * 9 + ksrc) * 1024 + 256 * u.pn) * 1024;
        return true;
    }
};
struct EpiDft {
    unsigned char* ws;
    __device__ __forceinline__ const float* scales(const Unit&) const { return nullptr; }
    __device__ __forceinline__ void operator()(AccRef acc, const Unit& u, int wr, int wc, int fr, int fq, const LAS float* sc) const {
        const int b = u.pm >> 4, k1 = u.pm & 15;
#pragma unroll
        for (int ai = 0; ai < 2; ++ai) {
            bf16* base = (bf16*)(ws + WS_F) + ((size_t)(ai * NB + b) * KH) * 2048 + 256 * u.pn + wc * 32 + 8 * fq;
#pragma unroll
            for (int m = 0; m < 4; ++m) {
                const int k = k1 + 16 * (wr * 64 + fr + m * 16);
#pragma unroll
                for (int bj = 0; bj < 2; ++bj) {
                    const f32x4 v0 = acc[ai][bj][m][0], v1 = acc[ai][bj][m][1];
                    u32x4 w; w.x = cvt_pk_bf16(v0[0], v0[1]); w.y = cvt_pk_bf16(v0[2], v0[3]); w.z = cvt_pk_bf16(v1[0], v1[1]); w.w = cvt_pk_bf16(v1[2], v1[3]);
                    *(u32x4*)(base + (size_t)k * 2048 + bj * 128) = w; } } }
    }
};
struct OrdWout {
    unsigned char* ws; int l, G, c, u0, u1;
    __device__ __forceinline__ bool next(int i, Unit& u) const {
        i += u0; if (i >= u1) return false;
        if (i >= 2 || c >= 256) return false;
        int pm, pn; pg8::tile_of(c, 256, 8, pm, pn);
        const int b = pm >> 3, kt = pm & 7;
        u.a = (const char*)((const bf16*)(ws + WS_F) + ((size_t)(i * NB + b) * KH + 256 * kt) * 2048);
        u.b = (const char*)((const bf16*)(ws + WS_WO2) + ((size_t)(l * 2 + i) * D + 256 * pn) * 2048);
        u.pm = pm | (i << 8); u.pn = pn;
        return true;
    }
};
struct EpiSD {
    unsigned char* ws; int bx;
    __device__ __forceinline__ const float* scales(const Unit&) const { return nullptr; }
    __device__ __forceinline__ void operator()(AccRef acc, const Unit& u, int wr, int wc, int fr, int fq, const LAS float* sc) const {
        bf16* ss = (bf16*)(ws + WS_SS) + (size_t)bx * 65536;
        if ((u.pm >> 8) == 0) { pg8::store_tile_bf16<false, false>(acc, ss, 256, nullptr, nullptr, wr, wc, fr, fq); return; }
        const int pm = u.pm & 255, b = pm >> 3, kt = pm & 7;
        const int row0 = wr * 64 + fr, col0 = wc * 32 + 8 * fq;
        bf16* xbb = (bf16*)(ws + WS_XB) + (size_t)(b * SEQ) * D + 256 * u.pn + col0; unsigned char* x8b = ws + WS_XS + (size_t)(b * SEQ) * D + 256 * u.pn + col0;
        u32x4 sw[2][2], r0[2][2], r1[2][2];
#define SD_LOAD(bf_, it_) do { const int r_ = row0 + ((it_) >> 2) * 128 + ((it_) & 3) * 16, k_ = 256 * kt + r_, km_ = (k_ == 0) ? 0 : SEQ - k_; \
            _Pragma("unroll") for (int bj = 0; bj < 2; ++bj) { sw[bf_][bj] = *(const u32x4*)(ss + (size_t)r_ * 256 + col0 + bj * 128); \
                r0[bf_][bj] = *(const u32x4*)(xbb + (size_t)k_ * D + bj * 128); r1[bf_][bj] = *(const u32x4*)(xbb + (size_t)km_ * D + bj * 128); } } while (0)
        SD_LOAD(0, 0);
#pragma unroll
        for (int it = 0; it < 8; ++it) {
            const int ai = it >> 2, m = it & 3, bf = it & 1;
            const int r = row0 + ai * 128 + m * 16, k = 256 * kt + r, km = (k == 0) ? 0 : SEQ - k;
            if (it + 1 < 8) SD_LOAD(bf ^ 1, it + 1);
#pragma unroll
            for (int bj = 0; bj < 2; ++bj) {
                const u32x4 swv = sw[bf][bj];
                const f32x4 s0 = (f32x4){bf_lo(swv.x), bf_hi(swv.x), bf_lo(swv.y), bf_hi(swv.y)}, s1 = (f32x4){bf_lo(swv.z), bf_hi(swv.z), bf_lo(swv.w), bf_hi(swv.w)};
                const f32x4 d0 = acc[ai][bj][m][0], d1 = acc[ai][bj][m][1];
                { const u32x4 rr = r0[bf][bj];
                  const f32x4 v0 = (s0 + d0) + (f32x4){bf_lo(rr.x), bf_hi(rr.x), bf_lo(rr.y), bf_hi(rr.y)}, v1 = (s1 + d1) + (f32x4){bf_lo(rr.z), bf_hi(rr.z), bf_lo(rr.w), bf_hi(rr.w)};
                  u32x4 w; w.x = cvt_pk_bf16(v0[0], v0[1]); w.y = cvt_pk_bf16(v0[2], v0[3]); w.z = cvt_pk_bf16(v1[0], v1[1]); w.w = cvt_pk_bf16(v1[2], v1[3]);
                  *(u32x4*)(xbb + (size_t)k * D + bj * 128) = w;
                  u32x2 q; q.x = pk4_fp8(v0[0], v0[1], v0[2], v0[3]); q.y = pk4_fp8(v1[0], v1[1], v1[2], v1[3]); *(u32x2*)(x8b + (size_t)k * D + bj * 128) = q; }
                if (k != 0) { const u32x4 rr = r1[bf][bj];
                  const f32x4 v0 = (s0 - d0) + (f32x4){bf_lo(rr.x), bf_hi(rr.x), bf_lo(rr.y), bf_hi(rr.y)}, v1 = (s1 - d1) + (f32x4){bf_lo(rr.z), bf_hi(rr.z), bf_lo(rr.w), bf_hi(rr.w)};
                  u32x4 w; w.x = cvt_pk_bf16(v0[0], v0[1]); w.y = cvt_pk_bf16(v0[2], v0[3]); w.z = cvt_pk_bf16(v1[0], v1[1]); w.w = cvt_pk_bf16(v1[2], v1[3]);
                  *(u32x4*)(xbb + (size_t)km * D + bj * 128) = w;
                  u32x2 q; q.x = pk4_fp8(v0[0], v0[1], v0[2], v0[3]); q.y = pk4_fp8(v1[0], v1[1], v1[2], v1[3]); *(u32x2*)(x8b + (size_t)km * D + bj * 128) = q; }
            }
            asm volatile("" ::: "memory");
        }
#undef SD_LOAD
    }
};
struct OrdFfn1 {
    unsigned char* ws; int l, G, c, u0, u1;
    __device__ __forceinline__ bool next(int i, Unit& u) const {
        i += u0; if (i >= u1) return false;
        const int L = i * G + c; if (L >= 2048) return false;
        pg8::tile_of(L, 2048, 16, u.pm, u.pn);
        u.a = (const char*)(ws + WS_XS);
        u.b = (const char*)(ws + WS_WGU) + ((size_t)(l * NE + (u.pm >> 3)) * 4096 + 256 * u.pn) * D;
        return true;
    }
};
struct EpiSwiglu {
    unsigned char* ws;
    __device__ __forceinline__ const float* scales(const Unit& u) const { return (const float*)(ws + WS_SRS) + 256 * u.pm; }
    __device__ __forceinline__ void operator()(AccRef acc, const Unit& u, int wr, int wc, int fr, int fq, const LAS float* sc) const {
        unsigned char* base = ws + WS_HID + (size_t)(256 * u.pm) * D + 128 * u.pn;
        const int row0 = wr * 64 + fr, col0 = wc * 32 + 8 * fq;
#pragma unroll
        for (int ai = 0; ai < 2; ++ai)
#pragma unroll
            for (int m = 0; m < 4; ++m) {
                const int r = row0 + ai * 128 + m * 16;
                const float rs = sc[r] * (1.0f / W8_SCALE), kt = rs * -1.44269504089f, ik2 = __builtin_amdgcn_rcpf(rs * rs * H8_SCALE);
                float h[8];
#pragma unroll
                for (int n = 0; n < 2; ++n)
#pragma unroll
                    for (int j = 0; j < 4; j += 2) {
                        const f32x2 ag = (f32x2){acc[ai][0][m][n][j], acc[ai][0][m][n][j + 1]}, au = (f32x2){acc[ai][1][m][n][j], acc[ai][1][m][n][j + 1]};
                        const f32x2 t = ag * kt;
                        f32x2 d; d.x = __builtin_amdgcn_exp2f(t.x); d.y = __builtin_amdgcn_exp2f(t.y);
                        d = d * ik2 + ik2;
                        f32x2 rc; rc.x = __builtin_amdgcn_rcpf(d.x); rc.y = __builtin_amdgcn_rcpf(d.y);
                        const f32x2 hv = (ag * au) * rc;
                        h[n * 4 + j] = __builtin_amdgcn_fmed3f(hv.x, -448.f, 448.f); h[n * 4 + j + 1] = __builtin_amdgcn_fmed3f(hv.y, -448.f, 448.f);
                    }
                u32x2 w; w.x = pk4_fp8(h[0], h[1], h[2], h[3]); w.y = pk4_fp8(h[4], h[5], h[6], h[7]);
                *(u32x2*)(base + (size_t)r * D + col0) = w; }
    }
};
struct OrdFfn2 {
    unsigned char* ws; int l, G, c, u0, u1;
    __device__ __forceinline__ bool next(int i, Unit& u) const {
        i += u0; if (i >= u1) return false;
        const int L = i * G + c; if (L >= 1024) return false;
        pg8::tile_of(L, 1024, 8, u.pm, u.pn);
        u.a = (const char*)(ws + WS_HID) + (size_t)(256 * u.pm) * D;
        u.b = (const char*)(ws + WS_WD) + ((size_t)(l * NE + (u.pm >> 3)) * D + 256 * u.pn) * D;
        return true;
    }
};
struct EpiDown {
    unsigned char* ws;
    __device__ __forceinline__ const float* scales(const Unit& u) const { return (const float*)(ws + WS_SGT) + 256 * u.pm; }
    __device__ __forceinline__ void operator()(AccRef acc, const Unit& u, int wr, int wc, int fr, int fq, const LAS float* sc) const {
        unsigned char* base = ws + WS_YS + (size_t)(256 * u.pm) * D + 256 * u.pn;
        const int row0 = wr * 64 + fr, col0 = wc * 32 + 8 * fq;
#pragma unroll
        for (int ai = 0; ai < 2; ++ai)
#pragma unroll
            for (int m = 0; m < 4; ++m) {
                const int r = row0 + ai * 128 + m * 16;
                const float scl = sc[r] * (YS8_SCALE / (W8_SCALE * H8_SCALE));
#pragma unroll
                for (int bj = 0; bj < 2; ++bj) { f32x4 v0 = acc[ai][bj][m][0] * scl, v1 = acc[ai][bj][m][1] * scl;
#pragma unroll
                    for (int j = 0; j < 4; ++j) { v0[j] = __builtin_amdgcn_fmed3f(v0[j], -448.f, 448.f); v1[j] = __builtin_amdgcn_fmed3f(v1[j], -448.f, 448.f); }
                    u32x2 q; q.x = pk4_fp8(v0[0], v0[1], v0[2], v0[3]); q.y = pk4_fp8(v1[0], v1[1], v1[2], v1[3]);
                    *(u32x2*)(base + (size_t)r * D + col0 + bj * 128) = q; } }
    }
};

__device__ __forceinline__ void tr_tile(const float* W, int ldw, const float* ks, bf16* dst, int dld, int k0, int n0, int drow0, int kd0, int lane) {
    const int kr = lane >> 4, nq = lane & 15;
    const float* src = W + (size_t)(k0 + 16 * kr) * ldw + n0 + 4 * nq;
    f32x4 v[16];
#pragma unroll
    for (int i = 0; i < 16; ++i) v[i] = __builtin_nontemporal_load((const f32x4*)(src + (size_t)i * ldw));
    if (ks) {
        const f32x4* kp = (const f32x4*)(ks + k0 + 16 * kr);
#pragma unroll
        for (int i4 = 0; i4 < 4; ++i4) { const f32x4 s = kp[i4];
#pragma unroll
            for (int j = 0; j < 4; ++j) v[i4 * 4 + j] = v[i4 * 4 + j] * s[j]; }
    }
#pragma unroll
    for (int j = 0; j < 4; ++j) {
        bf16* o = dst + (size_t)(drow0 + 4 * nq + j) * dld + kd0 + 16 * kr;
        u32x4 w0, w1;
        w0.x = cvt_pk_bf16(v[0][j], v[1][j]); w0.y = cvt_pk_bf16(v[2][j], v[3][j]); w0.z = cvt_pk_bf16(v[4][j], v[5][j]); w0.w = cvt_pk_bf16(v[6][j], v[7][j]);
        w1.x = cvt_pk_bf16(v[8][j], v[9][j]); w1.y = cvt_pk_bf16(v[10][j], v[11][j]); w1.z = cvt_pk_bf16(v[12][j], v[13][j]); w1.w = cvt_pk_bf16(v[14][j], v[15][j]);
        *(u32x4*)o = w0; *(u32x4*)(o + 8) = w1;
    }
}
struct Tr8 { const float* wg; const float* wu; const float* wd; const float* g2; unsigned char* ws; LAS unsigned char* lds; int wave, lane; };
__device__ __forceinline__ void tr8_load(const Tr8& T, int lw, int it, f32x4 (&v)[16]) {
    const int mid = it >> 7, r = it & 127, n0 = (r & 7) * 256, k0 = (r >> 3) * 128, le = lw * 16 + (mid & 15), kind = mid >> 4;
    const float* src = (kind == 0 ? T.wg : kind == 1 ? T.wu : T.wd) + (size_t)le * D * D + (size_t)(k0 + 16 * T.wave) * D + n0 + 4 * T.lane;
#pragma unroll
    for (int i = 0; i < 16; ++i) v[i] = __builtin_nontemporal_load((const f32x4*)(src + (size_t)i * D));
}
__device__ __forceinline__ void tr8_proc(const Tr8& T, int lw, int it, f32x4 (&v)[16], int p) {
    constexpr int PITCH = 144, IMG = 256 * PITCH;
    const int mid = it >> 7, r = it & 127, n0 = (r & 7) * 256, k0 = (r >> 3) * 128, le = lw * 16 + (mid & 15), kind = mid >> 4;
    if (kind < 2) { const float* ks = T.g2 + (le >> 4) * D + k0 + 16 * T.wave;
#pragma unroll
        for (int i = 0; i < 16; ++i) v[i] = v[i] * (ks[i] * W8_SCALE); }
    else {
#pragma unroll
        for (int i = 0; i < 16; ++i) v[i] = v[i] * W8_SCALE; }
    LAS unsigned char* img = T.lds + p * IMG;
#pragma unroll
    for (int j = 0; j < 4; ++j) { u32x4 w;
        w.x = pk4_fp8(v[0][j], v[1][j], v[2][j], v[3][j]); w.y = pk4_fp8(v[4][j], v[5][j], v[6][j], v[7][j]);
        w.z = pk4_fp8(v[8][j], v[9][j], v[10][j], v[11][j]); w.w = pk4_fp8(v[12][j], v[13][j], v[14][j], v[15][j]);
        *(LAS u32x4*)(img + (4 * T.lane + j) * PITCH + 16 * T.wave) = w; }
    asm volatile("s_waitcnt lgkmcnt(0)" ::: "memory"); __builtin_amdgcn_s_barrier(); asm volatile("" ::: "memory");
    unsigned char* dst = (kind < 2) ? T.ws + WS_WGU + (size_t)le * 4096 * D : T.ws + WS_WD + (size_t)le * D * D;
#pragma unroll
    for (int q = 0; q < 4; ++q) {
        const int row = 32 * T.wave + 8 * q + (T.lane >> 3), ch = T.lane & 7, n = n0 + row;
        const int drow = (kind < 2) ? ((n >> 7) * 256 + (n & 127) + (kind == 1 ? 128 : 0)) : n;
        const u32x4 w = *(const LAS u32x4*)(img + row * PITCH + 16 * ch);
        __builtin_nontemporal_store(w, (u32x4*)(dst + (size_t)drow * D + k0 + 16 * ch)); }
}
__device__ __forceinline__ void p_conv(Frame& F, int j0, int j1) {
    const Tr8 T{F.w_g, F.w_u, F.w_d, F.g2, F.ws, F.lds, F.wave, F.lane};
    f32x4 va[16], vb[16];
    int j = j0, p = 0;
#define CV_LW(j_) ((j_) >= 24 ? 1 : 0)
#define CV_IT(j_) (((j_) - 24 * CV_LW(j_)) * F.G + F.bx)
    if (j < j1) tr8_load(T, CV_LW(j), CV_IT(j), va);
    while (j < j1) {
        const int j2 = j + 1; if (j2 < j1) tr8_load(T, CV_LW(j2), CV_IT(j2), vb);
        tr8_proc(T, CV_LW(j), CV_IT(j), va, p); p ^= 1;
        if (j2 >= j1) break;
        const int j3 = j2 + 1; if (j3 < j1) tr8_load(T, CV_LW(j3), CV_IT(j3), va);
        tr8_proc(T, CV_LW(j2), CV_IT(j2), vb, p); p ^= 1;
        j = j3;
    }
    __syncthreads();
#undef CV_LW
#undef CV_IT
}
__device__ __forceinline__ void add8_fp8(f32x4 (&v)[2], u32x2 w, float sc) {
    const f32x2 a = __builtin_amdgcn_cvt_pk_f32_fp8((int)w.x, false), b = __builtin_amdgcn_cvt_pk_f32_fp8((int)w.x, true), c = __builtin_amdgcn_cvt_pk_f32_fp8((int)w.y, false), d = __builtin_amdgcn_cvt_pk_f32_fp8((int)w.y, true);
    v[0] = v[0] + (f32x4){a.x, a.y, b.x, b.y} * sc; v[1] = v[1] + (f32x4){c.x, c.y, d.x, d.y} * sc;
}
__device__ __forceinline__ void row_pass(Frame& F, int row, bool from_x, bool final_out) {
    const int lane = F.lane;
    f32x4 v[4][2];
    if (from_x) { const float* sp = F.x + (size_t)row * D + 8 * lane;
#pragma unroll
        for (int j = 0; j < 4; ++j) { v[j][0] = *(const f32x4*)(sp + 512 * j); v[j][1] = *(const f32x4*)(sp + 512 * j + 4); } }
    else {
        const int* sel = (const int*)(F.ws + WS_SEL) + (size_t)row * NE;
        const int sv = (lane < NE) ? sel[lane] : -1;
        const bf16* bp = (const bf16*)(F.ws + WS_XB) + (size_t)row * D + 8 * lane;
#pragma unroll
        for (int j = 0; j < 4; ++j) { const u32x4 w = *(const u32x4*)(bp + 512 * j);
            v[j][0] = (f32x4){bf_lo(w.x), bf_hi(w.x), bf_lo(w.y), bf_hi(w.y)}; v[j][1] = (f32x4){bf_lo(w.z), bf_hi(w.z), bf_lo(w.w), bf_hi(w.w)}; }
        unsigned long long m = __ballot(sv >= 0);
        const int b = row >> 12;
        const unsigned char* ybase = F.ws + WS_YS + (size_t)(b * CAP) * D + 8 * lane;
        while (m) {
            const int e0 = __builtin_ctzll(m); m &= m - 1;
            const bool two = (m != 0ull);
            const int e1 = two ? __builtin_ctzll(m) : e0; if (two) m &= m - 1;
            const int s0 = __builtin_amdgcn_readlane(sv, e0), s1 = __builtin_amdgcn_readlane(sv, e1);
            const unsigned char* y0 = ybase + ((size_t)e0 * ESL + s0) * D; const unsigned char* y1 = ybase + ((size_t)e1 * ESL + s1) * D;
            u32x2 w0[4], w1[4];
#pragma unroll
            for (int j = 0; j < 4; ++j) { w0[j] = *(const u32x2*)(y0 + 512 * j); w1[j] = *(const u32x2*)(y1 + 512 * j); }
#pragma unroll
            for (int j = 0; j < 4; ++j) add8_fp8(v[j], w0[j], 1.0f / YS8_SCALE);
            if (two) {
#pragma unroll
                for (int j = 0; j < 4; ++j) add8_fp8(v[j], w1[j], 1.0f / YS8_SCALE); }
        }
    }
    float ss = 0.f;
#pragma unroll
    for (int j = 0; j < 4; ++j)
#pragma unroll
        for (int h = 0; h < 2; ++h) ss += (v[j][h][0] * v[j][h][0] + v[j][h][1] * v[j][h][1]) + (v[j][h][2] * v[j][h][2] + v[j][h][3] * v[j][h][3]);
    const float inv = 1.f / sqrtf(wave_sum(ss, lane) * (1.f / D) + RMS_EPS);
    if (final_out) {
        float* op = F.out + (size_t)row * D + 8 * lane; const float* gp = F.gf + 8 * lane;
        f32x4 gq[4][2];
#pragma unroll
        for (int j = 0; j < 4; ++j) { gq[j][0] = *(const f32x4*)(gp + 512 * j); gq[j][1] = *(const f32x4*)(gp + 512 * j + 4); }
#pragma unroll
        for (int j = 0; j < 4; ++j)
#pragma unroll
            for (int h = 0; h < 2; ++h) *(f32x4*)(op + 512 * j + 4 * h) = v[j][h] * inv * gq[j][h];
    } else {
        bf16* bp = (bf16*)(F.ws + WS_XB) + (size_t)row * D + 8 * lane;
#pragma unroll
        for (int j = 0; j < 4; ++j) { u32x4 w; w.x = cvt_pk_bf16(v[j][0][0], v[j][0][1]); w.y = cvt_pk_bf16(v[j][0][2], v[j][0][3]); w.z = cvt_pk_bf16(v[j][1][0], v[j][1][1]); w.w = cvt_pk_bf16(v[j][1][2], v[j][1][3]);
            *(u32x4*)(bp + 512 * j) = w; }
        if (lane == 0) ((float*)(F.ws + WS_RMS1))[row] = inv;
    }
}
__device__ __forceinline__ bf16 f2bf(float v) { return (bf16)(cvt_pk_bf16(v, 0.f) & 0xffffu); }
__device__ __forceinline__ void p_prep(Frame& F) {
    LAS float* ctab = (LAS float*)F.lds;
    for (int i = F.tid; i < 4096; i += 512) ctab[i] = cospif((float)i * (1.0f / 2048.0f));
    __syncthreads();
    const int gt = F.bx * 512 + F.tid, NGT = F.G * 512;
    for (int i = gt; i < 512 * 256; i += NGT) {
        const int j = i >> 8, m = i & 255, ph = ((j & 255) * m) & 255;
        const float v = (j < 256) ? ctab[ph * 16] : -ctab[(ph * 16 + 3072) & 4095];
        ((bf16*)(F.ws + WS_CCS))[i] = f2bf(v * (1.0f / 1024.0f));
    }
    for (int i = gt; i < 16 * 256 * 512; i += NGT) {
        const int k1 = i >> 17, r = (i >> 9) & 255, kk = i & 511, p = r >> 7, k2 = r & 127, ri = kk >> 8, l2 = kk & 255, ph = ((k1 + 16 * k2) * l2) & 4095;
        const float c = ctab[ph], sn = ctab[(ph + 3072) & 4095], sg = (k1 <= 8) ? 1.f : -1.f;
        ((bf16*)(F.ws + WS_CS))[i] = f2bf(p == 0 ? (ri == 0 ? c : -sg * sn) : (ri == 0 ? sn : sg * c));
    }
    for (int i = gt; i < NL * 4 * 65536; i += NGT) {
        ((bf16*)(F.ws + WS_WF))[i] = f2bf(F.w_f[i]);
        const int lg = i >> 16, d = i & 255;
        ((bf16*)(F.ws + WS_WPS))[i] = f2bf(F.w_p[i] * F.p_s[lg * 256 + d]);
    }
    for (int i = gt; i < NL * NE * D; i += NGT) {
        const int l = i / (NE * D), e = (i / D) % NE, k = i % D;
        ((bf16*)(F.ws + WS_WR))[i] = f2bf(F.g2[l * D + k] * F.w_r[((size_t)l * D + k) * NE + e]);
    }
    for (int r = F.gw; r < T; r += F.NGW) row_pass(F, r, true, false);
    for (int it = F.gw; it < 4 * 1024; it += F.NGW) {
        const int mid = it >> 10, tile = it & 1023, k0 = (tile >> 5) * 64, n0 = (tile & 31) * 64;
        if (mid < 2) tr_tile(F.w_in + (size_t)mid * D * D, D, F.g1 + mid * D, (bf16*)(F.ws + WS_WIN) + (size_t)mid * D * D, D, k0, n0, n0, k0, F.lane);
        else tr_tile(F.w_out + (size_t)(mid - 2) * D * D, D, nullptr, (bf16*)(F.ws + WS_WOT) + ((size_t)(mid - 2) * 8 + (k0 >> 8)) * D * 256, 256, k0, n0, n0, k0 & 255, F.lane);
    }
}

__device__ __forceinline__ void ld8(const bf16* p, float (&o)[8]) { const u32x4 w = *(const u32x4*)p; o[0] = bf_lo(w.x); o[1] = bf_hi(w.x); o[2] = bf_lo(w.y); o[3] = bf_hi(w.y); o[4] = bf_lo(w.z); o[5] = bf_hi(w.z); o[6] = bf_lo(w.w); o[7] = bf_hi(w.w); }
template <int H, int MODE  >
__device__ __forceinline__ void pool_pass(const bf16* up, int r0, u32x4 (&pm)[8], bf16* fs, bf16* fd, float* ny, int t0) {
    u32x4 slot[8 + 2 * H];
#pragma unroll
    for (int s = 0; s < 8 + 2 * H; ++s) { const int row = r0 - H + s; slot[s] = (row >= 0 && row < SEQ) ? *(const u32x4*)(up + (size_t)row * 1024) : (u32x4){0u, 0u, 0u, 0u}; }
    float sum[8];
#pragma unroll
    for (int j = 0; j < 8; ++j) sum[j] = 0.f;
#pragma unroll
    for (int s = 0; s < 2 * H; ++s) { const u32x4 w = slot[s];
        sum[0] += bf_lo(w.x); sum[1] += bf_hi(w.x); sum[2] += bf_lo(w.y); sum[3] += bf_hi(w.y); sum[4] += bf_lo(w.z); sum[5] += bf_hi(w.z); sum[6] += bf_lo(w.w); sum[7] += bf_hi(w.w); }
#pragma unroll
    for (int i = 0; i < (MODE == 2 ? 1 : 8); ++i) {
        const int t = r0 + i;
        const int lo = (t - H) < 0 ? 0 : (t - H), hi = (t + H) > SEQ ? SEQ : (t + H);
        const float rc = (t < SEQ) ? 1.0f / (float)(hi - lo) : 0.f;
        u32x4 c = slot[i + H]; asm volatile("" : "+v"(c));
        const float cv[8] = {bf_lo(c.x), bf_hi(c.x), bf_lo(c.y), bf_hi(c.y), bf_lo(c.z), bf_hi(c.z), bf_lo(c.w), bf_hi(c.w)};
        float o8[8];
#pragma unroll
        for (int j = 0; j < 8; ++j) o8[j] = (t < SEQ) ? sum[j] * rc - cv[j] : 0.f;
        if constexpr (MODE == 0) {
            pm[i].x = cvt_pk_bf16(o8[0], o8[1]); pm[i].y = cvt_pk_bf16(o8[2], o8[3]); pm[i].z = cvt_pk_bf16(o8[4], o8[5]); pm[i].w = cvt_pk_bf16(o8[6], o8[7]);
        } else if constexpr (MODE == 1) {
            const bool first = (t0 + i == 0);
            const u32x4 mw = pm[7 - i];
            const float mv[8] = {bf_lo(mw.x), bf_hi(mw.x), bf_lo(mw.y), bf_hi(mw.y), bf_lo(mw.z), bf_hi(mw.z), bf_lo(mw.w), bf_hi(mw.w)};
            float ps[8], pd[8];
#pragma unroll
            for (int q = 0; q < 8; ++q) { const float a = o8[q], m = mv[q]; ps[q] = first ? a : 0.5f * (a + m); pd[q] = first ? 0.f : 0.5f * (a - m); }
            u32x4 w; w.x = cvt_pk_bf16(ps[0], ps[1]); w.y = cvt_pk_bf16(ps[2], ps[3]); w.z = cvt_pk_bf16(ps[4], ps[5]); w.w = cvt_pk_bf16(ps[6], ps[7]);
            *(u32x4*)(fs + (size_t)i * 2048) = w;
            w.x = cvt_pk_bf16(pd[0], pd[1]); w.y = cvt_pk_bf16(pd[2], pd[3]); w.z = cvt_pk_bf16(pd[4], pd[5]); w.w = cvt_pk_bf16(pd[6], pd[7]);
            *(u32x4*)(fd + (size_t)i * 2048) = w;
        } else { *(f32x4*)ny = (f32x4){o8[0], o8[1], o8[2], o8[3]}; *(f32x4*)(ny + 4) = (f32x4){o8[4], o8[5], o8[6], o8[7]}; }
        if (i < 7 && MODE != 2) { const u32x4 a = slot[i + 2 * H]; u32x4 d = slot[i]; asm volatile("" : "+v"(d));
            sum[0] += bf_lo(a.x) - bf_lo(d.x); sum[1] += bf_hi(a.x) - bf_hi(d.x); sum[2] += bf_lo(a.y) - bf_lo(d.y); sum[3] += bf_hi(a.y) - bf_hi(d.y);
            sum[4] += bf_lo(a.z) - bf_lo(d.z); sum[5] += bf_hi(a.z) - bf_hi(d.z); sum[6] += bf_lo(a.w) - bf_lo(d.w); sum[7] += bf_hi(a.w) - bf_hi(d.w); }
    }
}
template <int H>
__device__ __forceinline__ void pool_item(unsigned char* ws, int b, int c, int chunk) {
    const int t0 = chunk * 8;
    const bf16* up = (const bf16*)(ws + WS_UP) + (size_t)b * SEQ * 1024 + c;
    bf16* fs = (bf16*)(ws + WS_F) + ((size_t)b * KH + t0) * 2048 + 1024 + c; bf16* fd = fs + (size_t)NB * KH * 2048;
    float* ny = (float*)(ws + WS_NY) + (size_t)b * 2048 + 1024 + c;
    u32x4 pmr[8];
    pool_pass<H, 0>(up, SEQ - t0 - 7, pmr, fs, fd, ny, t0);
    asm volatile("" ::: "memory");
    pool_pass<H, 1>(up, t0, pmr, fs, fd, ny, t0);
    asm volatile("" ::: "memory");
    if (chunk == 255) pool_pass<H, 2>(up, 2048, pmr, fs, fd, ny, t0);
}
__device__ __forceinline__ void p_pool(Frame& F) {
    for (int it = F.wave * F.G + F.bx; it < 2048; it += F.NGW) {
        const int b = it >> 9, g = (it >> 7) & 3, chunk = 2 * (it & 127) + (F.lane >> 5), c = 256 * g + 8 * (F.lane & 31);
        switch (g) {
            case 0: pool_item<1>(F.ws, b, c, chunk); break;
            case 1: pool_item<2>(F.ws, b, c, chunk); break;
            case 2: pool_item<4>(F.ws, b, c, chunk); break;
            default: pool_item<8>(F.ws, b, c, chunk); break;
        }
    }
}

__device__ __forceinline__ void p_fft1(Frame& F) {
    constexpr float C16[16] = {1.f, 0.92387953251f, 0.70710678119f, 0.38268343236f, 0.f, -0.38268343236f, -0.70710678119f, -0.92387953251f, -1.f, -0.92387953251f, -0.70710678119f, -0.38268343236f, 0.f, 0.38268343236f, 0.70710678119f, 0.92387953251f};
    for (int it = F.bx * 512 + F.tid; it < NB * 1024 * 64; it += F.G * 512) {
        const int j4 = it & 63, bc = it >> 6, b = bc >> 10, c = bc & 1023, l2 = 4 * j4;
        const bf16* up = (const bf16*)(F.ws + WS_UT) + (size_t)bc * SEQ + l2;
        f32x4 x[16];
#pragma unroll
        for (int l1 = 0; l1 < 16; ++l1) { const u32x2 w = *(const u32x2*)(up + 256 * l1); x[l1] = (f32x4){bf_lo(w.x), bf_hi(w.x), bf_lo(w.y), bf_hi(w.y)}; }
        {
            float ny = 0.f;
#pragma unroll
            for (int l1 = 0; l1 < 16; ++l1) ny += (x[l1][0] - x[l1][1]) + (x[l1][2] - x[l1][3]);
            ny = wave_sum(ny, F.lane);
            if (F.lane == 0) ((float*)(F.ws + WS_NY))[(size_t)b * 2048 + c] = ny;
        }
        f32x4 t0[4], t1r[4], t1s[4], t2[4];
#pragma unroll
        for (int bp = 0; bp < 4; ++bp) { const f32x4 e = x[bp] + x[8 + bp], o = x[4 + bp] + x[12 + bp]; t0[bp] = e + o; t2[bp] = e - o; t1r[bp] = x[bp] - x[8 + bp]; t1s[bp] = x[4 + bp] - x[12 + bp]; }
        bf16* zp = (bf16*)(F.ws + WS_ZT) + (((size_t)(b * 9) * 1024 + c) * 2) * 256 + l2;
#pragma unroll
        for (int k1 = 0; k1 <= 8; ++k1) {
            const int q = k1 & 3;
            f32x4 yr = (f32x4){0.f, 0.f, 0.f, 0.f}, ys = yr;
#pragma unroll
            for (int bp = 0; bp < 4; ++bp) {
                const float ca = C16[(k1 * bp) & 15], sa = C16[((k1 * bp) + 12) & 15];
                const f32x4 tr = (q == 0) ? t0[bp] : (q == 2) ? t2[bp] : t1r[bp];
                if (q & 1) { const f32x4 ts = (q == 1) ? t1s[bp] : (f32x4){0.f, 0.f, 0.f, 0.f} - t1s[bp];
                    yr = yr + tr * ca - ts * sa; ys = ys + tr * sa + ts * ca; }
                else { yr = yr + tr * ca; ys = ys + tr * sa; }
            }
            u32x2 w0, w1;
            w0.x = cvt_pk_bf16(yr[0], yr[1]); w0.y = cvt_pk_bf16(yr[2], yr[3]); w1.x = cvt_pk_bf16(ys[0], ys[1]); w1.y = cvt_pk_bf16(ys[2], ys[3]);
            bf16* o = zp + (size_t)k1 * (1024 * 512);
            *(u32x2*)o = w0; *(u32x2*)(o + 256) = w1;
        }
    }
}

__device__ __forceinline__ void p_row2048(Frame& F, int l) {
    const int gwi = F.wave * F.G + F.bx;
    if (gwi >= NB * 512) return;
    const int b = gwi >> 9, n0 = (gwi & 511) * 4;
    const float* ny = (const float*)(F.ws + WS_NY) + (size_t)b * 2048 + 8 * F.lane;
    f32x4 a[4][2];
#pragma unroll
    for (int i = 0; i < 4; ++i) { a[i][0] = *(const f32x4*)(ny + 512 * i); a[i][1] = *(const f32x4*)(ny + 512 * i + 4); }
    const bf16* wrow = (const bf16*)(F.ws + WS_WO2) + ((size_t)(l * 2) * D + n0) * 2048 + 8 * F.lane;
    bf16* xb = (bf16*)(F.ws + WS_XB) + (size_t)(b * SEQ + 2048) * D + n0; unsigned char* x8 = F.ws + WS_XS + (size_t)(b * SEQ + 2048) * D + n0;
    const u32x2 xr = *(const u32x2*)xb;
    const float xres[4] = {bf_lo(xr.x), bf_hi(xr.x), bf_lo(xr.y), bf_hi(xr.y)};
    u32x4 wv[4][4];
#pragma unroll
    for (int j = 0; j < 4; ++j)
#pragma unroll
        for (int i = 0; i < 4; ++i) wv[j][i] = *(const u32x4*)(wrow + (size_t)j * 2048 + 512 * i);
    float dv[4];
#pragma unroll
    for (int j = 0; j < 4; ++j) {
        float d = 0.f;
#pragma unroll
        for (int i = 0; i < 4; ++i) { const u32x4 q = wv[j][i];
            d += (a[i][0][0] * bf_lo(q.x) + a[i][0][1] * bf_hi(q.x)) + (a[i][0][2] * bf_lo(q.y) + a[i][0][3] * bf_hi(q.y)) + (a[i][1][0] * bf_lo(q.z) + a[i][1][1] * bf_hi(q.z)) + (a[i][1][2] * bf_lo(q.w) + a[i][1][3] * bf_hi(q.w)); }
        dv[j] = wave_sum(d, F.lane);
    }
    if (F.lane == 0) {
#pragma unroll
        for (int j = 0; j < 4; ++j) { const float v = dv[j] + xres[j]; xb[j] = f2bf(v); x8[j] = (unsigned char)(pk4_fp8(v, 0.f, 0.f, 0.f) & 0xffu); }
    }
}

__device__ __forceinline__ void p_router(Frame& F, int l) {
    const int fr = F.lane & 15, fq = F.lane >> 4;
    for (int it = F.wave * F.G + F.bx; it < T / 16; it += F.NGW) {
        const int tok0 = it * 16;
        const bf16* xp = (const bf16*)(F.ws + WS_XB) + (size_t)(tok0 + fr) * D + 8 * fq;
        const bf16* wp = (const bf16*)(F.ws + WS_WR) + (size_t)l * NE * D + (size_t)fr * D + 8 * fq;
        f32x4 acc = (f32x4){0.f, 0.f, 0.f, 0.f}; float ss = 0.f;
#pragma unroll 16
        for (int ks = 0; ks < D / 32; ++ks) {
            const u32x4 xa = *(const u32x4*)(xp + 32 * ks); const u32x4 wb = *(const u32x4*)(wp + 32 * ks);
            ss += bf_lo(xa.x) * bf_lo(xa.x) + bf_hi(xa.x) * bf_hi(xa.x) + bf_lo(xa.y) * bf_lo(xa.y) + bf_hi(xa.y) * bf_hi(xa.y)
                + bf_lo(xa.z) * bf_lo(xa.z) + bf_hi(xa.z) * bf_hi(xa.z) + bf_lo(xa.w) * bf_lo(xa.w) + bf_hi(xa.w) * bf_hi(xa.w);
            acc = __builtin_amdgcn_mfma_f32_16x16x32_bf16(__builtin_bit_cast(bf16x8, wb), __builtin_bit_cast(bf16x8, xa), acc, 0, 0, 0);
        }
        ss += shx(ss, 16, F.lane); ss += shx(ss, 32, F.lane);
        const float inv = 1.f / sqrtf(ss * (1.f / D) + RMS_EPS);
        float z[4], mx;
#pragma unroll
        for (int j = 0; j < 4; ++j) z[j] = acc[j] * inv;
        mx = fmaxf(fmaxf(z[0], z[1]), fmaxf(z[2], z[3])); mx = fmaxf(mx, shx(mx, 16, F.lane)); mx = fmaxf(mx, shx(mx, 32, F.lane));
        float sm = 0.f;
#pragma unroll
        for (int j = 0; j < 4; ++j) { z[j] = __expf(z[j] - mx); sm += z[j]; }
        sm += shx(sm, 16, F.lane); sm += shx(sm, 32, F.lane);
        const float rsm = 1.f / sm;
        const int tok = tok0 + fr, b = tok >> 12, t = tok & 4095;
        float* pp = (float*)(F.ws + WS_PROB) + ((size_t)b * NE + 4 * fq) * SEQ + t;
#pragma unroll
        for (int j = 0; j < 4; ++j) pp[(size_t)j * SEQ] = z[j] * rsm;
        if (fq == 0) ((float*)(F.ws + WS_RMS2))[tok] = inv;
    }
}

__device__ __forceinline__ void p_topk(Frame& F, int l) {
    if (F.bx >= NB * NE) return;
    const int b = F.bx >> 4, e = F.bx & 15, tid = F.tid, lane = F.lane, wave = F.wave;
    LAS unsigned* red = (LAS unsigned*)F.lds;
    const float* pp = (const float*)(F.ws + WS_PROB) + ((size_t)b * NE + e) * SEQ + 8 * tid;
    unsigned key[8];
    float rv[8];
    { const float* r2p = (const float*)(F.ws + WS_RMS2) + (size_t)b * SEQ + 8 * tid; const f32x4 ra = *(const f32x4*)r2p, rb = *(const f32x4*)(r2p + 4);
      const u32x4 a = *(const u32x4*)pp, c = *(const u32x4*)(pp + 4); key[0] = a.x; key[1] = a.y; key[2] = a.z; key[3] = a.w; key[4] = c.x; key[5] = c.y; key[6] = c.z; key[7] = c.w;
      rv[0] = ra[0]; rv[1] = ra[1]; rv[2] = ra[2]; rv[3] = ra[3]; rv[4] = rb[0]; rv[5] = rb[1]; rv[6] = rb[2]; rv[7] = rb[3]; }
    unsigned thr = 0u;
    int itn = 0;
    for (int hi = 30; hi >= 0; hi -= 2, ++itn) {
        const bool pair = (hi >= 1);
        const unsigned bh = 1u << hi, bl = pair ? (1u << (hi - 1)) : 0u;
        const unsigned c10 = thr | bh, c11 = thr | bh | bl, c01 = thr | bl;
        unsigned n10 = 0, n11 = 0, n01 = 0;
#pragma unroll
        for (int j = 0; j < 8; ++j) { n10 += (unsigned)__popcll(__ballot(key[j] >= c10)); n11 += (unsigned)__popcll(__ballot(key[j] >= c11)); n01 += (unsigned)__popcll(__ballot(key[j] >= c01)); }
        LAS unsigned* slot = red + (itn & 1) * 24;
        if (lane == 0) { slot[wave] = n10; slot[8 + wave] = n11; slot[16 + wave] = n01; }
        __syncthreads();
        unsigned t10 = 0, t11 = 0, t01 = 0;
#pragma unroll
        for (int w = 0; w < 8; ++w) { t10 += slot[w]; t11 += slot[8 + w]; t01 += slot[16 + w]; }
        if (pair) thr = (t11 >= (unsigned)CAP) ? c11 : (t10 >= (unsigned)CAP) ? c10 : (t01 >= (unsigned)CAP) ? c01 : thr;
        else      thr = (t10 >= (unsigned)CAP) ? c10 : thr;
    }
    __syncthreads();
    unsigned cg = 0, ce = 0;
#pragma unroll
    for (int j = 0; j < 8; ++j) { cg += (key[j] > thr) ? 1u : 0u; ce += (key[j] == thr) ? 1u : 0u; }
    const unsigned pk = cg | (ce << 16); unsigned inc = pk;
#pragma unroll
    for (int o = 1; o < 64; o <<= 1) { const unsigned v = (unsigned)__builtin_amdgcn_ds_bpermute((lane - o) << 2, (int)inc); if (lane >= o) inc += v; }
    LAS unsigned* wtot = red + 64;
    if (lane == 63) wtot[wave] = inc;
    __syncthreads();
    unsigned base = 0, total = 0;
#pragma unroll
    for (int w = 0; w < 8; ++w) { const unsigned v = wtot[w]; if (w < wave) base += v; total += v; }
    const unsigned excl = base + inc - pk;
    unsigned pg = excl & 0xffffu, pe = excl >> 16;
    const unsigned ngt = total & 0xffffu, need_eq = (unsigned)CAP - ngt;
    unsigned* roff = (unsigned*)(F.ws + WS_ROFF) + ((size_t)l * NE + e) * ESL + b * CAP;
    float* srs = (float*)(F.ws + WS_SRS) + (size_t)e * ESL + b * CAP;
    float* sgt = (float*)(F.ws + WS_SGT) + (size_t)e * ESL + b * CAP;
    int* sel = (int*)(F.ws + WS_SEL) + ((size_t)b * SEQ + 8 * tid) * NE + e;
#pragma unroll
    for (int j = 0; j < 8; ++j) {
        int s = -1;
        if (key[j] > thr) { s = (int)pg; ++pg; }
        else if (key[j] == thr) { if (pe < need_eq) s = (int)(ngt + pe); ++pe; }
        sel[(size_t)j * NE] = s;
        if (s >= 0) { roff[s] = (unsigned)((b * SEQ + 8 * tid + j) * D); srs[s] = rv[j]; sgt[s] = __builtin_bit_cast(float, key[j]); }
    }
    __syncthreads();
}

struct RowIn { u32x4 xw[4]; u32x2 ya[4], yb[4]; int sv, e0, e1; unsigned long long rest; bool any, two; };
__device__ __forceinline__ int comb_sv(const Frame& F, int row) { const int* sel = (const int*)(F.ws + WS_SEL) + (size_t)row * NE; return (F.lane < NE) ? sel[F.lane] : -1; }
__device__ __forceinline__ void comb_load(const Frame& F, int row, int sv, RowIn& R) {
    R.sv = sv;
    const bf16* bp = (const bf16*)(F.ws + WS_XB) + (size_t)row * D + 8 * F.lane;
#pragma unroll
    for (int j = 0; j < 4; ++j) R.xw[j] = *(const u32x4*)(bp + 512 * j);
    unsigned long long m = __ballot(sv >= 0);
    R.any = (m != 0ull);
    const int e0 = R.any ? __builtin_ctzll(m) : 0; m &= m - 1;
    R.two = (m != 0ull);
    const int e1 = R.two ? __builtin_ctzll(m) : e0; if (R.two) m &= m - 1;
    R.e0 = e0; R.e1 = e1; R.rest = m;
    if (R.any) {
        const int b = row >> 12;
        const unsigned char* ybase = F.ws + WS_YS + (size_t)(b * CAP) * D + 8 * F.lane;
        const int s0 = __builtin_amdgcn_readlane(sv, e0), s1 = __builtin_amdgcn_readlane(sv, e1);
        const unsigned char* y0 = ybase + ((size_t)e0 * ESL + s0) * D; const unsigned char* y1 = ybase + ((size_t)e1 * ESL + s1) * D;
#pragma unroll
        for (int j = 0; j < 4; ++j) { R.ya[j] = *(const u32x2*)(y0 + 512 * j); R.yb[j] = *(const u32x2*)(y1 + 512 * j); }
    } else {
#pragma unroll
        for (int j = 0; j < 4; ++j) { R.ya[j] = (u32x2){0u, 0u}; R.yb[j] = (u32x2){0u, 0u}; }
    }
}
__device__ __forceinline__ void comb_proc(Frame& F, int row, const RowIn& R, bool final_out) {
    const int lane = F.lane;
    f32x4 v[4][2];
#pragma unroll
    for (int j = 0; j < 4; ++j) { const u32x4 w = R.xw[j];
        v[j][0] = (f32x4){bf_lo(w.x), bf_hi(w.x), bf_lo(w.y), bf_hi(w.y)}; v[j][1] = (f32x4){bf_lo(w.z), bf_hi(w.z), bf_lo(w.w), bf_hi(w.w)}; }
    if (R.any) {
#pragma unroll
        for (int j = 0; j < 4; ++j) add8_fp8(v[j], R.ya[j], 1.0f / YS8_SCALE);
        if (R.two) {
#pragma unroll
            for (int j = 0; j < 4; ++j) add8_fp8(v[j], R.yb[j], 1.0f / YS8_SCALE); }
    }
    const int sv = R.sv;
    unsigned long long m = R.rest;
    const int b = row >> 12;
    const unsigned char* ybase = F.ws + WS_YS + (size_t)(b * CAP) * D + 8 * lane;
    while (m) {
        const int e0 = __builtin_ctzll(m); m &= m - 1;
        const bool two = (m != 0ull);
        const int e1 = two ? __builtin_ctzll(m) : e0; if (two) m &= m - 1;
        const int s0 = __builtin_amdgcn_readlane(sv, e0), s1 = __builtin_amdgcn_readlane(sv, e1);
        const unsigned char* y0 = ybase + ((size_t)e0 * ESL + s0) * D; const unsigned char* y1 = ybase + ((size_t)e1 * ESL + s1) * D;
        u32x2 w0[4], w1[4];
#pragma unroll
        for (int j = 0; j < 4; ++j) { w0[j] = *(const u32x2*)(y0 + 512 * j); w1[j] = *(const u32x2*)(y1 + 512 * j); }
#pragma unroll
        for (int j = 0; j < 4; ++j) add8_fp8(v[j], w0[j], 1.0f / YS8_SCALE);
        if (two) {
#pragma unroll
            for (int j = 0; j < 4; ++j) add8_fp8(v[j], w1[j], 1.0f / YS8_SCALE); }
    }
    float ss = 0.f;
#pragma unroll
    for (int j = 0; j < 4; ++j)
#pragma unroll
        for (int h = 0; h < 2; ++h) ss += (v[j][h][0] * v[j][h][0] + v[j][h][1] * v[j][h][1]) + (v[j][h][2] * v[j][h][2] + v[j][h][3] * v[j][h][3]);
    const float inv = 1.f / sqrtf(wave_sum(ss, lane) * (1.f / D) + RMS_EPS);
    if (final_out) {
        float* op = F.out + (size_t)row * D + 8 * lane; const float* gp = F.gf + 8 * lane;
        f32x4 gq[4][2];
#pragma unroll
        for (int j = 0; j < 4; ++j) { gq[j][0] = *(const f32x4*)(gp + 512 * j); gq[j][1] = *(const f32x4*)(gp + 512 * j + 4); }
#pragma unroll
        for (int j = 0; j < 4; ++j)
#pragma unroll
            for (int h = 0; h < 2; ++h) *(f32x4*)(op + 512 * j + 4 * h) = v[j][h] * inv * gq[j][h];
    } else {
        bf16* bp = (bf16*)(F.ws + WS_XB) + (size_t)row * D + 8 * lane;
#pragma unroll
        for (int j = 0; j < 4; ++j) { u32x4 w; w.x = cvt_pk_bf16(v[j][0][0], v[j][0][1]); w.y = cvt_pk_bf16(v[j][0][2], v[j][0][3]); w.z = cvt_pk_bf16(v[j][1][0], v[j][1][1]); w.w = cvt_pk_bf16(v[j][1][2], v[j][1][3]);
            *(u32x4*)(bp + 512 * j) = w; }
        if (lane == 0) ((float*)(F.ws + WS_RMS1))[row] = inv;
    }
}
__device__ __forceinline__ void p_combine(Frame& F, bool final_out) {
    RowIn A, B;
    int r = F.wave * F.G + F.bx;
    int svA = (r < T) ? comb_sv(F, r) : -1;
    int svB = (r + F.NGW < T) ? comb_sv(F, r + F.NGW) : -1;
    if (r < T) comb_load(F, r, svA, A);
    while (r < T) {
        const int r2 = r + F.NGW, r3 = r2 + F.NGW, r4 = r3 + F.NGW;
        svA = (r3 < T) ? comb_sv(F, r3) : -1;
        if (r2 < T) comb_load(F, r2, svB, B);
        comb_proc(F, r, A, final_out);
        if (r2 >= T) break;
        svB = (r4 < T) ? comb_sv(F, r4) : -1;
        if (r3 < T) comb_load(F, r3, svA, A);
        comb_proc(F, r2, B, final_out);
        r = r3;
    }
}

constexpr int PPL = 8, N_PHASES = 1 + PPL * NL;
__global__ void __launch_bounds__(512, 2) fwd(Args args) {
    extern __shared__ __attribute__((aligned(16))) unsigned char lds_raw[];
    Frame F;
    F.lds = (LAS unsigned char*)lds_raw;
    F.tid = 0; F.lane = 0; F.wave = __builtin_amdgcn_readfirstlane(threadIdx.x >> 6);
    F.G = gridDim.x; F.gw = blockIdx.x * 8 + F.wave; F.NGW = F.G * 8;
    F.x = args.in[0]; F.g1 = args.in[1]; F.w_in = args.in[2]; F.w_f = args.in[3]; F.w_p = args.in[4]; F.p_s = args.in[5]; F.w_out = args.in[6];
    F.g2 = args.in[7]; F.w_r = args.in[8]; F.w_g = args.in[9]; F.w_u = args.in[10]; F.w_d = args.in[11]; F.gf = args.in[12];
    F.out = args.out; F.ws = args.ws;
    volatile LAS unsigned* misc = (volatile LAS unsigned*)(F.lds + MISC_OFF);
    if (threadIdx.x < 64) misc[threadIdx.x] = 0u;
    __syncthreads();
    unsigned* barw = (unsigned*)(F.ws + WS_CTL) + CW_BAR;
    XcdBarrier bar; bar.bar = barw; bar.x = 0; bar.st = nullptr;
    if (!MK_PER_PHASE) bar = xcd_barrier_post(barw, misc + 8);
    const int lo = args.ph_lo, hi = args.ph_hi;
#if MK_PER_PHASE
#define IN(k) (lo <= (k) && (k) < hi)
#else
#define IN(k) true
#endif
#define SEAM(k, mn_) do { if (IN(k) && IN((k) + 1)) { int wv_ = F.wave; asm volatile("" : "+s"(wv_)); const bool mem_ = xcd_barrier_arrive(bar, wv_, (unsigned)nbar); \
        if (SHADOW && mem_ && cvn >= (mn_) && cvn < 48) { LAUNDER; p_conv(Fp, cvn, cvn + 1); ++cvn; } \
        xcd_barrier_finish(bar, wv_, (unsigned)nbar); ++nbar; } } while (0)
    LAS unsigned char* ring = F.lds;
    F.bx = (int)blockIdx.x;

#define RLOOP(bit) _Pragma("nounroll") for (int rep_ = 0; rep_ < ((REP & (bit)) ? 2 : 1); ++rep_)
#define LAUNDER Frame Fp = F; { unsigned long long z_ = 0ull; asm volatile("" : "+s"(z_)); Fp.ws = F.ws + z_; }     asm volatile("" : "+s"(Fp.wave)); asm volatile("" : "+s"(Fp.bx)); Fp.gw = Fp.bx * 8 + Fp.wave; asm volatile("v_mbcnt_lo_u32_b32 %0, -1, 0\n\tv_mbcnt_hi_u32_b32 %0, -1, %0" : "=v"(Fp.lane)); Fp.tid = Fp.wave * 64 + Fp.lane
    RLOOP(1) if (IN(0)) { LAUNDER; p_prep(Fp); __syncthreads(); }
    int nbar = 0;
    int cvn = 0;
    SEAM(0, 0);
#define PHASEG(ng_, nu_, j0_, j1_, ...) { const int grp_ = (F.bx >> 3) % (ng_); const bool cv_ = cvn < (j1_); const int split_ = cv_ ? (grp_ * (nu_) * 2 + ((ng_) - 1)) / (2 * ((ng_) - 1)) : (nu_); \
    _Pragma("nounroll") for (int s_ = 0; s_ < 2; ++s_) { const int u0_ = s_ ? split_ : 0, u1_ = s_ ? (nu_) : split_; \
        if (u1_ > u0_) { __VA_ARGS__ } \
        if (s_ == 0 && cv_) { LAUNDER; p_conv(Fp, cvn, j1_); cvn = (j1_); } } }
#pragma nounroll
    for (int l = 0; l < NL; ++l) {
        const int pb = 1 + PPL * l;
        const int cW0 = l ? 28 : 0, cW1 = l ? 33 : 6, cO0 = l ? 33 : 6, cO1 = l ? 40 : 16, cF0 = l ? 40 : 16, cF1 = l ? 48 : 24, cG0 = 24, cG1 = l ? 24 : 28;
        if (l == 0) { LAUNDER; OrdFold S{Fp.ws, 0, F.G, Fp.bx}; EpiFold E{Fp.ws, 0}; pg8::gemm_phase<4, 512, false, false, false>(ring, Fp.wave, S, E); }
        PHASEG(3, 2, cW0, cW1, { LAUNDER; OrdWin S{Fp.ws, l, F.G, Fp.bx, u0_, u1_}; EpiWin E{Fp.ws}; pg8::gemm_phase<D / 64, D * 2, false, false, true>(ring, Fp.wave, S, E); })
        SEAM(pb + 0, l ? 24 : 0);
        if (l == 0) { LAUNDER; OrdFold S{Fp.ws, 1, F.G, Fp.bx}; EpiFold E{Fp.ws, 1}; pg8::gemm_phase<4, 512, false, false, false>(ring, Fp.wave, S, E); }
        { LAUNDER; p_fft1(Fp); p_pool(Fp); }
        SEAM(pb + 1, l ? 24 : 0);
        PHASEG(2, 1, 0, 0, { LAUNDER; OrdDft S{Fp.ws, F.G, Fp.bx, u0_, u1_}; EpiDft E{Fp.ws}; pg8::gemm_phase<8, 1024, false, false, false>(ring, Fp.wave, S, E); })
        SEAM(pb + 1, l ? 24 : 0);
        { LAUNDER; p_row2048(Fp, l); }
        PHASEG(3, 2, cO0, cO1, { LAUNDER; OrdWout S{Fp.ws, l, F.G, Fp.bx, u0_, u1_}; EpiSD E{Fp.ws, Fp.bx}; pg8::gemm_phase<KH / 64, KH * 2, false, false, false>(ring, Fp.wave, S, E); })
        SEAM(pb + 2, l ? 24 : 0);
        { LAUNDER; p_router(Fp, l); }
        SEAM(pb + 3, l ? 24 : 0);
        { LAUNDER; p_topk(Fp, l); }
        SEAM(pb + 4, l ? 40 : 16);
        PHASEG(8, 8, cF0, cF1, { LAUNDER; OrdFfn1 S{Fp.ws, l, F.G, Fp.bx, u0_, u1_}; EpiSwiglu E{Fp.ws}; pg8::gemm_phase<D / 128, D, true, true, true>(ring, Fp.wave, S, E, (const unsigned*)(Fp.ws + WS_ROFF) + (size_t)l * NE * ESL); })
        SEAM(pb + 5, l ? 48 : 24);
        PHASEG(5, 4, cG0, cG1, { LAUNDER; OrdFfn2 S{Fp.ws, l, F.G, Fp.bx, u0_, u1_}; EpiDown E{Fp.ws}; pg8::gemm_phase<D / 128, D, true, false, true>(ring, Fp.wave, S, E); })
        SEAM(pb + 6, l ? 48 : 24);
        { LAUNDER; p_combine(Fp, l == NL - 1); }
        if (l + 1 < NL) SEAM(pb + 7, 24);
    }
#undef PHASEG
#undef LAUNDER
#undef RLOOP
#undef IN
#undef SEAM
}

extern "C" void kernel_launch(void* const* d_in, const int* in_sizes, int n_in, void* d_out, int out_size, void* d_ws, size_t ws_size, hipStream_t stream) {
    static int grid = 0;
    if (grid == 0) {
        if (n_in != 13 || in_sizes[0] != T * D || out_size != T * D || ws_size < WS_END) {
            fprintf(stderr, "kernel_launch: unexpected shapes (n_in %d, in0 %d, out %d, ws %zu < %zu); nothing launched\n", n_in, n_in > 0 ? in_sizes[0] : -1, out_size, ws_size, (size_t)WS_END); grid = -1; return; }
        int dev = 0, cus = 0, per_cu = 0;
        if (hipGetDevice(&dev) != hipSuccess || hipDeviceGetAttribute(&cus, hipDeviceAttributeMultiprocessorCount, dev) != hipSuccess) { fprintf(stderr, "kernel_launch: device query failed\n"); grid = -1; return; }
        if (hipFuncSetAttribute((const void*)fwd, hipFuncAttributeMaxDynamicSharedMemorySize, LDS_BYTES) != hipSuccess) { fprintf(stderr, "kernel_launch: hipFuncSetAttribute failed\n"); grid = -1; return; }
        if (hipOccupancyMaxActiveBlocksPerMultiprocessor(&per_cu, (const void*)fwd, 512, LDS_BYTES) != hipSuccess || per_cu < 1) fprintf(stderr, "kernel_launch: occupancy query reports %d\n", per_cu);
        (void)hipGetLastError();
        grid = cus;
        if (grid > 256) grid = 256;
        grid &= ~7;
        if (grid != 256) fprintf(stderr, "kernel_launch: this kernel's unit maps assume 256 workgroups (one per CU of a 256-CU device); got %d\n", grid);
    }
    if (grid <= 0) return;
    (void)hipMemsetAsync((char*)d_ws + WS_CTL, 0, CTL_ZERO_BYTES, stream);
    Args a{};
    for (int i = 0; i < 13; ++i) a.in[i] = (const float*)d_in[i];
    a.out = (float*)d_out; a.ws = (unsigned char*)d_ws;
#if MK_PER_PHASE
    for (int p = 0; p < N_PHASES; ++p) { a.ph_lo = p; a.ph_hi = p + 1; hipLaunchKernelGGL(fwd, dim3(grid), dim3(512), LDS_BYTES, stream, a); }
#else
    a.ph_lo = 0; a.ph_hi = N_PHASES;
    hipLaunchKernelGGL(fwd, dim3(grid), dim3(512), LDS_BYTES, stream, a);
#endif
    const hipError_t le = hipPeekAtLastError();
    if (le != hipSuccess) fprintf(stderr, "kernel_launch: launch failed: %s\n", hipGetErrorName(le));
}
```

```cpp
#include <hip/hip_runtime.h>
#include <cstdio>
#include <cstdint>

#ifndef SHADOW
#define SHADOW 1
#endif
#ifndef REP
#define REP 0
#endif
#ifndef MK_PER_PHASE
#define MK_PER_PHASE 0
#endif

#define GAS __attribute__((address_space(1)))
#define LAS __attribute__((address_space(3)))
#define CAS __attribute__((address_space(4)))
typedef unsigned short bf16;
typedef short bf16x8 __attribute__((ext_vector_type(8)));
typedef float f32x4 __attribute__((ext_vector_type(4)));
typedef unsigned u32x4 __attribute__((ext_vector_type(4)));
typedef unsigned u32x2 __attribute__((ext_vector_type(2)));
typedef float f32x2 __attribute__((ext_vector_type(2)));

constexpr int NB = 4, SEQ = 4096, D = 2048, T = NB * SEQ, NL = 2, NE = 16, CAP = 512, ESL = NB * CAP  ;
constexpr int KH = 2048;
constexpr float RMS_EPS = 1e-6f;

constexpr size_t MiB = 1u << 20;
constexpr size_t WS_CTL = 0, CTL_ZERO_BYTES = 64 * 1024;
constexpr size_t WS_RMS1 = 1 * MiB;
constexpr size_t WS_RMS2 = WS_RMS1 + 64 * 1024;
constexpr size_t WS_WR   = WS_RMS2 + 64 * 1024;
constexpr size_t WS_CCS  = WS_WR + 128 * 1024;
constexpr size_t WS_SRS  = WS_CCS + 256 * 1024;
constexpr size_t WS_SGT  = WS_SRS + 128 * 1024;
constexpr size_t WS_ROFF = WS_SGT + 128 * 1024;
constexpr size_t WS_PROB = 2 * MiB;
constexpr size_t WS_SEL  = 3 * MiB;
constexpr size_t WS_WF   = 4 * MiB;
constexpr size_t WS_WPS  = 5 * MiB;
constexpr size_t WS_TT   = 6 * MiB;
constexpr size_t WS_WIN  = 16 * MiB;
constexpr size_t WS_WOT  = 32 * MiB;
constexpr size_t WS_WO2  = 48 * MiB;
constexpr size_t WS_NY   = 14 * MiB;
constexpr size_t WS_SS   = 264 * MiB;
constexpr size_t WS_CS   = 80 * MiB;
constexpr size_t WS_ZT   = 200 * MiB;
constexpr size_t WS_XB   = 136 * MiB;
constexpr size_t WS_UT   = 328 * MiB;
constexpr size_t WS_UP   = 360 * MiB;
constexpr size_t WS_F    = 392 * MiB;
constexpr size_t WS_HID  = 488 * MiB;
constexpr size_t WS_YS   = 616 * MiB;
constexpr size_t WS_XS   = 552 * MiB;
constexpr size_t WS_WGU  = 744 * MiB;
constexpr size_t WS_WD   = 1256 * MiB;
constexpr size_t WS_END  = 1512 * MiB;
constexpr int CW_BAR = 1024;

constexpr int RING_BYTES = 131072, MISC_OFF = RING_BYTES, GTAB_OFF = RING_BYTES + 1024, SCT_OFF = GTAB_OFF + 16384, LDS_BYTES = SCT_OFF + 3072;

__device__ __forceinline__ unsigned cvt_pk_bf16(float lo, float hi) { unsigned r; asm volatile("v_cvt_pk_bf16_f32 %0, %1, %2" : "=v"(r) : "v"(lo), "v"(hi)); return r; }
__device__ __forceinline__ float bf_lo(unsigned w) { return __builtin_bit_cast(float, w << 16); }
__device__ __forceinline__ float bf_hi(unsigned w) { return __builtin_bit_cast(float, w & 0xffff0000u); }
constexpr float W8_SCALE = 64.f, H8_SCALE = 8.f, YS8_SCALE = 64.f;
__device__ __forceinline__ unsigned pk4_fp8(float a, float b, float c, float d) { int w = __builtin_amdgcn_cvt_pk_fp8_f32(a, b, 0, false); w = __builtin_amdgcn_cvt_pk_fp8_f32(c, d, w, true); return (unsigned)w; }
__device__ __forceinline__ float shx(float v, int o, int lane) { return __builtin_bit_cast(float, __builtin_amdgcn_ds_bpermute((lane ^ o) << 2, __builtin_bit_cast(int, v))); }
__device__ __forceinline__ unsigned shxu(unsigned v, int o, int lane) { return (unsigned)__builtin_amdgcn_ds_bpermute((lane ^ o) << 2, (int)v); }
__device__ __forceinline__ float wave_sum(float v, int lane) {
#pragma unroll
    for (int o = 1; o < 64; o <<= 1) v += shx(v, o, lane);
    return v;
}
#define LDS_WAIT() asm volatile("s_waitcnt lgkmcnt(0)" ::: "memory")
#define VM_WAIT() asm volatile("s_waitcnt vmcnt(0)" ::: "memory")

#define XB_TMO      128
#define XB_XCNT(j)  (256  + 64 * (j))
#define XB_XSUB(j)  (1280 + 64 * (j))
#define XB_XGEN(j)  (2304 + 64 * (j))
#define XB_TOP      3328
#define XB_TOPGEN   3392
#define XCD_BAR_WORDS 3456
#define XB_SPIN_CAP (1u << 18)
__device__ __forceinline__ unsigned xb_ld(unsigned* p)              { return __hip_atomic_load(p, __ATOMIC_RELAXED, __HIP_MEMORY_SCOPE_AGENT); }
__device__ __forceinline__ unsigned xb_add(unsigned* p, unsigned v) { return __hip_atomic_fetch_add(p, v, __ATOMIC_RELAXED, __HIP_MEMORY_SCOPE_AGENT); }
__device__ __forceinline__ unsigned xb_xcc_id() { return (unsigned)__builtin_amdgcn_s_getreg((3 << 11) | 20) & 0xFu; }
#define XB_SPIN(cond, bar) do { unsigned _sp = 0; while (cond) { __builtin_amdgcn_s_sleep(1); \
    if ((++_sp & 255u) == 0u) { if (xb_ld(&(bar)[XB_TMO])) break; if (_sp > XB_SPIN_CAP) { atomicAdd(&(bar)[XB_TMO], 1u); break; } } } } while (0)
struct XcdBarrier { unsigned* bar; unsigned x; volatile LAS unsigned* st; };
__device__ __forceinline__ XcdBarrier xcd_barrier_post(unsigned* bar, volatile LAS unsigned* st) {
    XcdBarrier b; b.bar = bar; b.x = xb_xcc_id(); b.st = st;
    if (threadIdx.x == 0) st[2] = xb_add(&bar[XB_XCNT(b.x)], 1u);
    return b;
}
__device__ __forceinline__ void xcd_barrier_complete(unsigned* bar, unsigned x, unsigned& nloc, unsigned& nx) {
    const unsigned G = gridDim.x * gridDim.y * gridDim.z;
    unsigned sum, cnt, mine, sp = 0u;
    for (;;) {
        sum = 0u; cnt = 0u; mine = 0u;
#pragma unroll
        for (unsigned j = 0; j < 16; ++j) { const unsigned c = xb_ld(&bar[XB_XCNT(j)]); sum += c; cnt += (c > 0u) ? 1u : 0u; mine = (j == x) ? c : mine; }
        if (sum == G) break;
        __builtin_amdgcn_s_sleep(1);
        if ((++sp & 255u) == 0u) { if (xb_ld(&bar[XB_TMO])) break; if (sp > XB_SPIN_CAP) { atomicAdd(&bar[XB_TMO], 1u); break; } }
    }
    nloc = mine > 0u ? mine : 1u; nx = cnt > 0u ? cnt : 1u;
}
__device__ __forceinline__ void xcd_barrier(const XcdBarrier& b, const int wave_id) {
    asm volatile("s_waitcnt vmcnt(0)" ::: "memory");
    __syncthreads();
    int ln_; asm volatile("v_mbcnt_lo_u32_b32 %0, -1, 0\n\tv_mbcnt_hi_u32_b32 %0, -1, %0" : "=v"(ln_));
    if (wave_id == 0 && ln_ == 0) {
        unsigned* bar = b.bar; unsigned bx = b.x;
        asm volatile("" : "+s"(bar), "+s"(bx));
        __builtin_amdgcn_s_waitcnt(0);
        unsigned nloc = b.st[0], nx = b.st[1];
        if (nloc == 0u) { xcd_barrier_complete(bar, bx, nloc, nx); b.st[0] = nloc; b.st[1] = nx; }
        const unsigned old = xb_add(&bar[XB_XSUB(bx)], 1u);
        const unsigned gen = old / nloc;
        if (old + 1u == (gen + 1u) * nloc) {
            __builtin_amdgcn_fence(__ATOMIC_RELEASE, "agent");
            asm volatile("s_waitcnt vmcnt(0)" ::: "memory");
            const unsigned og = xb_add(&bar[XB_TOP], 1u);
            const unsigned tg = og / nx;
            if (og + 1u == (tg + 1u) * nx) xb_add(&bar[XB_TOPGEN], 1u);
            else XB_SPIN(xb_ld(&bar[XB_TOPGEN]) == tg, bar);
            __builtin_amdgcn_fence(__ATOMIC_ACQUIRE, "agent");
            xb_add(&bar[XB_XGEN(bx)], 1u);
            asm volatile("s_waitcnt vmcnt(0)" ::: "memory");
        } else {
            XB_SPIN(xb_ld(&bar[XB_XGEN(bx)]) == gen, bar);
            __builtin_amdgcn_fence(__ATOMIC_ACQUIRE, "agent");
            asm volatile("s_waitcnt vmcnt(0)" ::: "memory");
        }
    }
    __syncthreads();
}

__device__ __forceinline__ bool xcd_barrier_arrive(const XcdBarrier& b, const int wave_id, const unsigned nbar) {
    asm volatile("s_waitcnt vmcnt(0)" ::: "memory");
    __syncthreads();
    int ln_; asm volatile("v_mbcnt_lo_u32_b32 %0, -1, 0\n\tv_mbcnt_hi_u32_b32 %0, -1, %0" : "=v"(ln_));
    if (wave_id == 0 && ln_ == 0) {
        unsigned* bar = b.bar; unsigned bx = b.x;
        asm volatile("" : "+s"(bar), "+s"(bx));
        __builtin_amdgcn_s_waitcnt(0);
        unsigned nloc = b.st[0], nx = b.st[1];
        if (nloc == 0u) { xcd_barrier_complete(bar, bx, nloc, nx); b.st[0] = nloc; b.st[1] = nx; }
        (void)xb_add(&bar[XB_XSUB(bx)], 1u);
        b.st[3] = nbar;
    }
    __syncthreads();
    const unsigned nloc = (unsigned)__builtin_amdgcn_readfirstlane((int)b.st[0]), rank = (unsigned)__builtin_amdgcn_readfirstlane((int)b.st[2]);
    return rank != nbar % nloc;
}
__device__ __forceinline__ void xcd_barrier_finish(const XcdBarrier& b, const int wave_id, const unsigned nbar) {
    __syncthreads();
    int ln_; asm volatile("v_mbcnt_lo_u32_b32 %0, -1, 0\n\tv_mbcnt_hi_u32_b32 %0, -1, %0" : "=v"(ln_));
    if (wave_id == 0 && ln_ == 0) {
        unsigned* bar = b.bar; unsigned bx = b.x;
        asm volatile("" : "+s"(bar), "+s"(bx));
        const unsigned nloc = b.st[0], nx = b.st[1], gen = nbar;
        if (b.st[2] == gen % nloc) {
            XB_SPIN(xb_ld(&bar[XB_XSUB(bx)]) < (gen + 1u) * nloc, bar);
            __builtin_amdgcn_fence(__ATOMIC_RELEASE, "agent");
            asm volatile("s_waitcnt vmcnt(0)" ::: "memory");
            const unsigned og = xb_add(&bar[XB_TOP], 1u);
            const unsigned tg = og / nx;
            if (og + 1u == (tg + 1u) * nx) xb_add(&bar[XB_TOPGEN], 1u);
            else XB_SPIN(xb_ld(&bar[XB_TOPGEN]) == tg, bar);
            __builtin_amdgcn_fence(__ATOMIC_ACQUIRE, "agent");
            xb_add(&bar[XB_XGEN(bx)], 1u);
            asm volatile("s_waitcnt vmcnt(0)" ::: "memory");
        } else {
            XB_SPIN(xb_ld(&bar[XB_XGEN(bx)]) == gen, bar);
            __builtin_amdgcn_fence(__ATOMIC_ACQUIRE, "agent");
            asm volatile("s_waitcnt vmcnt(0)" ::: "memory");
        }
    }
    __syncthreads();
}

namespace pg8 {
constexpr int BM = 256, BK = 64, HALF = 128, HTB = HALF * BK * 2, STAGE_BYTES = 8 * HTB;
__device__ __forceinline__ int lds_byte(int r, int c) { const int st = (r >> 4) * 2 + (c >> 5), rr = r & 15, cc = c & 31, ob = rr * 64 + cc * 2; return st * 1024 + (ob ^ (((ob >> 9) & 1) << 5)); }
__device__ __forceinline__ void stage_rc(int b, int& R, int& C) { const int st = b / 1024, sb = b % 1024, swz = sb ^ (((sb >> 9) & 1) << 5); R = (st >> 1) * 16 + swz / 64; C = (st & 1) * 32 + (swz % 64) / 2; }
__device__ __forceinline__ int perm32(int rho) { const int n = rho >> 4, i = rho & 15; return 8 * (i >> 2) + 4 * n + (i & 3); }

typedef int i32x8 __attribute__((ext_vector_type(8)));
typedef double f64x2z __attribute__((ext_vector_type(2)));
typedef int i32x4 __attribute__((ext_vector_type(4)));
__device__ __forceinline__ i32x8 cat8(bf16x8 lo, bf16x8 hi) { const i32x4 a = __builtin_bit_cast(i32x4, lo), b = __builtin_bit_cast(i32x4, hi); return __builtin_shufflevector(a, b, 0, 1, 2, 3, 4, 5, 6, 7); }
struct Unit { const char* a; const char* b; int pm, pn; };

template <int NT  , int PITCH  , bool FP8  , bool GATHER, bool SCL  , class Epi, class Sched>
__device__ __forceinline__ void gemm_phase(LAS unsigned char* lds, const int wave_id, const Sched& S, const Epi& E, const unsigned* gro = nullptr) {
    int lane_; asm volatile("v_mbcnt_lo_u32_b32 %0, -1, 0\n\tv_mbcnt_hi_u32_b32 %0, -1, %0" : "=v"(lane_)); const int tid_ = wave_id * 64 + lane_;
    const int tid = tid_, wid = wave_id, lane = lane_, wr = wid >> 2, wc = wid & 3, fr = lane & 15, fq = lane >> 4;
    constexpr int nt = NT;
    static_assert(NT % 2 == 0 && NT >= 4, "K");
    unsigned voffA[2], voffB[2];
#pragma unroll
    for (int i = 0; i < 2; ++i) { int R, C; stage_rc(tid * 16 + i * 8192, R, C); const int Rb = (R & ~31) + perm32(R & 31);
        voffA[i] = GATHER ? (unsigned)(C * 2) : (unsigned)(R * PITCH + C * 2); voffB[i] = (unsigned)(Rb * PITCH + C * 2); }
    const unsigned gtab = (unsigned)(size_t)lds + (unsigned)STAGE_BYTES + 1024u;
    constexpr size_t kstep = (size_t)(BK * 2);
    constexpr size_t hstep = (size_t)HALF * PITCH;
    const unsigned ldsb = (unsigned)(size_t)lds + (unsigned)wid * 1024u;
    const int aoff = lds_byte(wr * 64 + fr, fq * 8), boff = lds_byte(wc * 32 + fr, fq * 8);
#define PG8_SA(b, h) (((b) * 2 + (h)) * HTB)
#define PG8_SB(b, h) ((4 + (b) * 2 + (h)) * HTB)
#define PG8_DMA16(voff_, sbase_, ldsdst_) do { unsigned _keep; asm volatile("s_mov_b32 m0, %2\n\ts_nop 0\n\tglobal_load_lds_dwordx4 %0, %1" :: "v"(voff_), "s"((const char*)(sbase_)), "s"(ldsdst_) : "memory", "m0"); (void)_keep; } while (0)
#define PG8_STAGE(bufoff, gbase, voff) do { _Pragma("unroll") for (int _i = 0; _i < 2; ++_i) PG8_DMA16((voff)[_i], gbase, ldsb + (unsigned)((bufoff) + _i * 8192)); } while (0)
#define PG8_STAGE_A(bufoff, gbase_, h_, tb_) do { if constexpr (GATHER) { _Pragma("unroll") for (int _i = 0; _i < 2; ++_i) { \
            const unsigned _o = *(const LAS unsigned*)(size_t)(gtab + (unsigned)(tb_) * 8192u + (unsigned)(((h_) * 2 + _i) * 2048) + (unsigned)tid * 4u) + voffA[0]; \
            PG8_DMA16(_o, gbase_, ldsb + (unsigned)((bufoff) + _i * 8192)); } } \
        else { PG8_STAGE(bufoff, (gbase_) + (h_) * hstep, voffA); } } while (0)
#define PG8_GFILL(tb_, ro_) do { _Pragma("unroll") for (int _h = 0; _h < 2; ++_h) _Pragma("unroll") for (int _i = 0; _i < 2; ++_i) { unsigned _keep; \
        asm volatile("s_mov_b32 m0, %2\n\ts_nop 0\n\tglobal_load_lds_dword %0, %1" :: "v"((unsigned)(lane & ~3)), "s"((const char*)(ro_) + _h * 512 + 64 * ((wid + 8 * _i) >> 1)), \
                     "s"(gtab + (unsigned)(tb_) * 8192u + (unsigned)((_h * 2 + _i) * 2048) + (unsigned)wid * 256u) : "memory", "m0"); (void)_keep; } } while (0)
#define PG8_SCFILL(buf_, ptr_) do { if (wid < 4) { unsigned _keep; const char* _p = (const char*)(ptr_) + wid * 256; \
        const unsigned _lo = (unsigned)__builtin_amdgcn_readfirstlane((int)(unsigned)(size_t)_p), _hi = (unsigned)__builtin_amdgcn_readfirstlane((int)(unsigned)((size_t)_p >> 32)); \
        const char* _ps = (const char*)(((size_t)_hi << 32) | (size_t)_lo); \
        asm volatile("s_mov_b32 m0, %2\n\ts_nop 0\n\tglobal_load_lds_dword %0, %1" :: "v"((unsigned)(lane * 4)), "s"(_ps), \
                     "s"((unsigned)(size_t)lds + (unsigned)(STAGE_BYTES + 1024 + 16384) + (unsigned)(buf_) * 1024u + (unsigned)wid * 256u) : "memory", "m0"); (void)_keep; } } while (0)
#define PG8_LDA(dst, b, h) do { _Pragma("unroll") for (int m = 0; m < 4; ++m) _Pragma("unroll") for (int k = 0; k < 2; ++k) dst[m][k] = *(const LAS bf16x8*)(lds + PG8_SA(b, h) + aoff + m * 2048 + k * 1024); } while (0)
#define PG8_LDB(dst, b, h) do { _Pragma("unroll") for (int n = 0; n < 2; ++n) _Pragma("unroll") for (int k = 0; k < 2; ++k) dst[n][k] = *(const LAS bf16x8*)(lds + PG8_SB(b, h) + boff + n * 2048 + k * 1024); } while (0)
#define PG8_MMA(ai, bj, At, Bt) do { __builtin_amdgcn_s_setprio(1); _Pragma("unroll") for (int m = 0; m < 4; ++m) _Pragma("unroll") for (int n = 0; n < 2; ++n) { \
        if constexpr (FP8) acc[ai][bj][m][n] = __builtin_amdgcn_mfma_scale_f32_16x16x128_f8f6f4(cat8(Bt[n][0], Bt[n][1]), cat8(At[m][0], At[m][1]), acc[ai][bj][m][n], 0, 0, 0, 0, 0, 0);     \
        else { _Pragma("unroll") for (int k = 0; k < 2; ++k) acc[ai][bj][m][n] = __builtin_amdgcn_mfma_f32_16x16x32_bf16(Bt[n][k], At[m][k], acc[ai][bj][m][n], 0, 0, 0); } } __builtin_amdgcn_s_setprio(0); } while (0)
#define PG8_WAIT_V(n) asm volatile("s_waitcnt vmcnt(" #n ")" ::: "memory")
#define PG8_WAIT_L(n) asm volatile("s_waitcnt lgkmcnt(" #n ")" ::: "memory")
#define PG8_BAR __builtin_amdgcn_s_barrier()
#define PG8_SCHED __builtin_amdgcn_sched_barrier(0)
    Unit cur, nxt; int ui = 0;
    if (!S.next(0, cur)) return;
    LAS float* const sctab = (LAS float*)(lds + STAGE_BYTES + 1024 + 16384);
    int sb = 0;
    if constexpr (SCL) { PG8_SCFILL(0, E.scales(cur)); }
    f32x4 acc[2][2][4][2];
#pragma unroll
    for (int a = 0; a < 2; ++a)
#pragma unroll
        for (int b = 0; b < 2; ++b)
#pragma unroll
            for (int m = 0; m < 4; ++m)
#pragma unroll
                for (int n = 0; n < 2; ++n) { double z0_, z1_; asm volatile("v_mov_b64 %0, 0\n\tv_mov_b64 %1, 0" : "=v"(z0_), "=v"(z1_)); acc[a][b][m][n] = __builtin_bit_cast(f32x4, (f64x2z){z0_, z1_}); }
    bf16x8 At[4][2], B0[2][2], B1[2][2];
    const char* cA = cur.a; const char* cB = cur.b;
    if constexpr (GATHER) { const int pm0 = __builtin_amdgcn_readfirstlane(cur.pm); PG8_GFILL(0, gro + 256 * pm0); }
    PG8_STAGE(PG8_SB(0, 0), cB, voffB); PG8_STAGE(PG8_SB(0, 1), cB + hstep, voffB);
    if constexpr (GATHER) PG8_WAIT_V(4);
    PG8_STAGE_A(PG8_SA(0, 0), cA, 0, 0); PG8_STAGE_A(PG8_SA(0, 1), cA, 1, 0);
    if (wr == 1) PG8_BAR;
    PG8_WAIT_V(2); PG8_BAR;
    PG8_STAGE(PG8_SB(1, 0), cB + kstep, voffB); PG8_STAGE_A(PG8_SA(1, 0), cA + kstep, 0, 0); PG8_STAGE(PG8_SB(1, 1), cB + hstep + kstep, voffB);
    PG8_WAIT_V(6); PG8_BAR;
    for (;;) {
        const bool has_next = S.next(ui + 1, nxt);
        const int sbn = (sb == 2) ? 0 : sb + 1;
        if constexpr (SCL) { if (has_next) PG8_SCFILL(sbn, E.scales(nxt)); }
        const char* nA = has_next ? nxt.a : cA + (size_t)(nt - 2) * kstep; const char* nB = has_next ? nxt.b : cB + (size_t)(nt - 2) * kstep;
        const int tbc = ui & 1, tbn = has_next ? (tbc ^ 1) : tbc;
        if constexpr (GATHER) { if (has_next) PG8_GFILL(tbn, gro + 256 * nxt.pm); }
        for (int t = 0; t < nt; t += 2) {
            const bool last = (t == nt - 2);
            const char* a1 = cA + (size_t)(t + 1) * kstep;
            const char* a2 = last ? nA : cA + (size_t)(t + 2) * kstep; const char* b2 = last ? nB : cB + (size_t)(t + 2) * kstep;
            const char* a3 = a2 + kstep; const char* b3 = b2 + kstep;
            const int tb2 = last ? tbn : tbc;
            PG8_LDB(B0, 0, 0); PG8_LDB(B1, 0, 1); PG8_SCHED; PG8_LDA(At, 0, 0); PG8_STAGE_A(PG8_SA(1, 1), a1, 1, tbc);
            PG8_WAIT_V(8); PG8_WAIT_L(0); PG8_BAR; PG8_MMA(0, 0, At, B0); PG8_MMA(0, 1, At, B1); PG8_BAR; PG8_SCHED;
            PG8_LDA(At, 0, 1); PG8_STAGE(PG8_SB(0, 0), b2, voffB); PG8_STAGE(PG8_SB(0, 1), b2 + hstep, voffB); PG8_STAGE_A(PG8_SA(0, 0), a2, 0, tb2);
            PG8_WAIT_V(8); PG8_WAIT_L(0); PG8_BAR; PG8_MMA(1, 0, At, B0); PG8_MMA(1, 1, At, B1); PG8_BAR; PG8_SCHED;
            PG8_LDB(B0, 1, 0); PG8_LDB(B1, 1, 1); PG8_SCHED; PG8_LDA(At, 1, 0); PG8_STAGE_A(PG8_SA(0, 1), a2, 1, tb2);
            PG8_WAIT_V(8); PG8_WAIT_L(0); PG8_BAR; PG8_MMA(0, 0, At, B0); PG8_MMA(0, 1, At, B1); PG8_BAR; PG8_SCHED;
            PG8_LDA(At, 1, 1); PG8_STAGE(PG8_SB(1, 0), b3, voffB); PG8_STAGE(PG8_SB(1, 1), b3 + hstep, voffB); PG8_STAGE_A(PG8_SA(1, 0), a3, 0, tb2);
            PG8_WAIT_V(8); PG8_WAIT_L(0); PG8_BAR; PG8_MMA(1, 0, At, B0); PG8_MMA(1, 1, At, B1); PG8_BAR; PG8_SCHED;
        }
        if (wr == 0) PG8_BAR;
        { int le_; asm volatile("v_mbcnt_lo_u32_b32 %0, -1, 0\n\tv_mbcnt_hi_u32_b32 %0, -1, %0" : "=v"(le_)); E(acc, cur, wr, wc, le_ & 15, le_ >> 4, (const LAS float*)(sctab + sb * 256)); }
        if (!has_next) break;
#pragma unroll
        for (int a = 0; a < 2; ++a)
#pragma unroll
            for (int b = 0; b < 2; ++b)
#pragma unroll
                for (int m = 0; m < 4; ++m)
#pragma unroll
                    for (int n = 0; n < 2; ++n) { double z0_, z1_; asm volatile("v_mov_b64 %0, 0\n\tv_mov_b64 %1, 0" : "=v"(z0_), "=v"(z1_)); acc[a][b][m][n] = __builtin_bit_cast(f32x4, (f64x2z){z0_, z1_}); }
        cur = nxt; cA = nA; cB = nB; ++ui; sb = sbn;
        if (wr == 1) PG8_BAR;
    }
    PG8_WAIT_V(0);
    PG8_BAR;
#undef PG8_SA
#undef PG8_SB
#undef PG8_STAGE
#undef PG8_STAGE_A
#undef PG8_DMA16
#undef PG8_GFILL
#undef PG8_SCFILL
#undef PG8_LDA
#undef PG8_LDB
#undef PG8_MMA
#undef PG8_WAIT_V
#undef PG8_WAIT_L
#undef PG8_BAR
#undef PG8_SCHED
}

__device__ __forceinline__ void tile_of(int L, int n, int nN, int& pm, int& pn) {
    const int q = n >> 3, w = (L & 7) * q + (L >> 3);
    const int nig = 8 * nN, gid = w / nig, rem = w % nig;
    pm = gid * 8 + (rem & 7); pn = rem >> 3;
}

__device__ __forceinline__ f32x4 ld4s(const float* p) { return *(const f32x4*)p; }
__device__ __forceinline__ f32x4 ld4s(const LAS float* p) { return *(const LAS f32x4*)p; }
template <class T> struct IdT { typedef T type; };
template <bool ROWS, bool COLS, class SP = const float*>
__device__ __forceinline__ void store_tile_bf16(const f32x4 (&acc)[2][2][4][2], bf16* base, int ldc, typename IdT<SP>::type rowscale, typename IdT<SP>::type colscale, int wr, int wc, int fr, int fq, const float gscale = 1.f) {
    const int row0 = wr * 64 + fr, col0 = wc * 32 + 8 * fq;
    f32x4 cs[2][2];
#pragma unroll
    for (int bj = 0; bj < 2; ++bj)
#pragma unroll
        for (int n = 0; n < 2; ++n) cs[bj][n] = COLS ? ld4s(colscale + col0 + bj * HALF + 4 * n) : (f32x4){1.f, 1.f, 1.f, 1.f};
#pragma unroll
    for (int ai = 0; ai < 2; ++ai)
#pragma unroll
        for (int m = 0; m < 4; ++m) {
            const int r = row0 + ai * HALF + m * 16;
            const float rs = ROWS ? rowscale[r] * gscale : 1.f;
            bf16* rowp = base + (size_t)r * ldc + col0;
#pragma unroll
            for (int bj = 0; bj < 2; ++bj) {
                f32x4 v0 = acc[ai][bj][m][0], v1 = acc[ai][bj][m][1];
                if (COLS) { v0 = v0 * cs[bj][0]; v1 = v1 * cs[bj][1]; }
                if (ROWS) { v0 = v0 * rs; v1 = v1 * rs; }
                u32x4 w; w.x = cvt_pk_bf16(v0[0], v0[1]); w.y = cvt_pk_bf16(v0[2], v0[3]); w.z = cvt_pk_bf16(v1[0], v1[1]); w.w = cvt_pk_bf16(v1[2], v1[3]);
                *(u32x4*)(rowp + bj * HALF) = w; } }
}
}
using pg8::Unit;
typedef const f32x4 (&AccRef)[2][2][4][2];

struct Args { const float* in[13]; float* out; unsigned char* ws; int ph_lo, ph_hi; };
struct Frame {
    LAS unsigned char* lds; int tid, lane, wave, G, gw, NGW, bx;
    const float *x, *g1, *w_in, *w_f, *w_p, *p_s, *w_out, *g2, *w_r, *w_g, *w_u, *w_d, *gf;
    float* out; unsigned char* ws;
};

struct OrdFold {
    unsigned char* ws; int stage, G, c;
    __device__ __forceinline__ bool next(int i, Unit& u) const {
        const int L = i * G + c; if (L >= 128) return false;
        const int l = L >> 6, r = L & 63, mt = r & 7, q = r >> 3;
        u.pm = L; u.pn = 0;
        if (stage == 0) {
            const int g = q & 3;
            u.a = (const char*)((const bf16*)(ws + WS_WOT) + ((size_t)(l * 8 + q) * D + 256 * mt) * 256);
            u.b = (const char*)((const bf16*)(ws + (q < 4 ? WS_WF : WS_WPS)) + (size_t)(l * 4 + g) * 65536);
        } else {
            const int g = q >> 1, nt = q & 1;
            u.a = (const char*)((const bf16*)(ws + WS_TT) + ((size_t)(l * 4 + g) * D + 256 * mt) * 256);
            u.b = (const char*)((const bf16*)(ws + WS_CCS) + (size_t)nt * 65536);
        }
        return true;
    }
};
struct EpiFold {
    unsigned char* ws; int stage;
    __device__ __forceinline__ const float* scales(const Unit&) const { return nullptr; }
    __device__ __forceinline__ void operator()(AccRef acc, const Unit& u, int wr, int wc, int fr, int fq, const LAS float* sc) const {
        const int L = u.pm, l = L >> 6, r = L & 63, mt = r & 7, q = r >> 3;
        bf16* wo2 = (bf16*)(ws + WS_WO2) + ((size_t)(l * 2) * D + 256 * mt) * 2048;
        if (stage == 0) { const int g = q & 3;
            if (q < 4) pg8::store_tile_bf16<false, false>(acc, (bf16*)(ws + WS_TT) + ((size_t)(l * 4 + g) * D + 256 * mt) * 256, 256, nullptr, nullptr, wr, wc, fr, fq);
            else { pg8::store_tile_bf16<false, false>(acc, wo2 + 1024 + 256 * g, 2048, nullptr, nullptr, wr, wc, fr, fq);
                   pg8::store_tile_bf16<false, false>(acc, wo2 + (size_t)D * 2048 + 1024 + 256 * g, 2048, nullptr, nullptr, wr, wc, fr, fq); } }
        else { const int g = q >> 1, nt = q & 1; pg8::store_tile_bf16<false, false>(acc, wo2 + (size_t)nt * D * 2048 + 256 * g, 2048, nullptr, nullptr, wr, wc, fr, fq); }
    }
};
struct OrdWin {
    unsigned char* ws; int l, G, c, u0, u1;
    __device__ __forceinline__ bool next(int i, Unit& u) const {
        i += u0; if (i >= u1) return false;
        const int L = i * G + c; if (L >= 512) return false;
        pg8::tile_of(L, 512, 8, u.pm, u.pn);
        const char* xb = (const char*)((const bf16*)(ws + WS_XB) + (size_t)(256 * u.pm) * D);
        const char* w = (const char*)((const bf16*)(ws + WS_WIN) + (size_t)l * D * D + (size_t)(256 * u.pn) * D);
        if (u.pn < 4) { u.a = w; u.b = xb; } else { u.a = xb; u.b = w; }
        return true;
    }
};
struct EpiWin {
    unsigned char* ws;
    __device__ __forceinline__ const float* scales(const Unit& u) const { return (const float*)(ws + WS_RMS1) + 256 * u.pm; }
    __device__ __forceinline__ void operator()(AccRef acc, const Unit& u, int wr, int wc, int fr, int fq, const LAS float* sc) const {
        if (u.pn < 4) { const int b = u.pm >> 4, l0 = (u.pm & 15) * 256;
            pg8::store_tile_bf16<false, true, const LAS float*>(acc, (bf16*)(ws + WS_UT) + ((size_t)(b * 1024 + 256 * u.pn)) * SEQ + l0, SEQ, nullptr, sc, wr, wc, fr, fq); }
        else pg8::store_tile_bf16<true, false, const LAS float*>(acc, (bf16*)(ws + WS_UP) + (size_t)(256 * u.pm) * 1024 + 256 * (u.pn - 4), 1024, sc, nullptr, wr, wc, fr, fq);
    }
};
struct OrdDft {
    unsigned char* ws; int G, c, u0, u1;
    __device__ __forceinline__ bool next(int i, Unit& u) const {
        i += u0; if (i >= u1) return false;
        const int L = i * G + c; if (L >= 256) return false;
        u.pm = L >> 2; u.pn = L & 3;
        const int b = u.pm >> 4, k1 = u.pm & 15, ksrc = (k1 <= 8) ? k1 : 16 - k1;
        u.a = (const char*)(ws + WS_CS) + (size_t)k1 * (256 * 512 * 2);
        u.b = (const char*)(ws + WS_ZT) + ((size_t)(b * 9 + ksrc) * 1024 + 256 * u.pn) * 1024;
        return true;
    }
};
struct EpiDft {
    unsigned char* ws;
    __device__ __forceinline__ const float* scales(const Unit&) const { return nullptr; }
    __device__ __forceinline__ void operator()(AccRef acc, const Unit& u, int wr, int wc, int fr, int fq, const LAS float* sc) const {
        const int b = u.pm >> 4, k1 = u.pm & 15;
#pragma unroll
        for (int ai = 0; ai < 2; ++ai) {
            bf16* base = (bf16*)(ws + WS_F) + ((size_t)(ai * NB + b) * KH) * 2048 + 256 * u.pn + wc * 32 + 8 * fq;
#pragma unroll
            for (int m = 0; m < 4; ++m) {
                const int k = k1 + 16 * (wr * 64 + fr + m * 16);
#pragma unroll
                for (int bj = 0; bj < 2; ++bj) {
                    const f32x4 v0 = acc[ai][bj][m][0], v1 = acc[ai][bj][m][1];
                    u32x4 w; w.x = cvt_pk_bf16(v0[0], v0[1]); w.y = cvt_pk_bf16(v0[2], v0[3]); w.z = cvt_pk_bf16(v1[0], v1[1]); w.w = cvt_pk_bf16(v1[2], v1[3]);
                    *(u32x4*)(base + (size_t)k * 2048 + bj * 128) = w; } } }
    }
};
struct OrdWout {
    unsigned char* ws; int l, G, c, u0, u1;
    __device__ __forceinline__ bool next(int i, Unit& u) const {
        i += u0; if (i >= u1) return false;
        if (i >= 2 || c >= 256) return false;
        int pm, pn; pg8::tile_of(c, 256, 8, pm, pn);
        const int b = pm >> 3, kt = pm & 7;
        u.a = (const char*)((const bf16*)(ws + WS_F) + ((size_t)(i * NB + b) * KH + 256 * kt) * 2048);
        u.b = (const char*)((const bf16*)(ws + WS_WO2) + ((size_t)(l * 2 + i) * D + 256 * pn) * 2048);
        u.pm = pm | (i << 8); u.pn = pn;
        return true;
    }
};
struct EpiSD {
    unsigned char* ws; int bx;
    __device__ __forceinline__ const float* scales(const Unit&) const { return nullptr; }
    __device__ __forceinline__ void operator()(AccRef acc, const Unit& u, int wr, int wc, int fr, int fq, const LAS float* sc) const {
        bf16* ss = (bf16*)(ws + WS_SS) + (size_t)bx * 65536;
        if ((u.pm >> 8) == 0) { pg8::store_tile_bf16<false, false>(acc, ss, 256, nullptr, nullptr, wr, wc, fr, fq); return; }
        const int pm = u.pm & 255, b = pm >> 3, kt = pm & 7;
        const int row0 = wr * 64 + fr, col0 = wc * 32 + 8 * fq;
        bf16* xbb = (bf16*)(ws + WS_XB) + (size_t)(b * SEQ) * D + 256 * u.pn + col0; unsigned char* x8b = ws + WS_XS + (size_t)(b * SEQ) * D + 256 * u.pn + col0;
        u32x4 sw[2][2], r0[2][2], r1[2][2];
#define SD_LOAD(bf_, it_) do { const int r_ = row0 + ((it_) >> 2) * 128 + ((it_) & 3) * 16, k_ = 256 * kt + r_, km_ = (k_ == 0) ? 0 : SEQ - k_; \
            _Pragma("unroll") for (int bj = 0; bj < 2; ++bj) { sw[bf_][bj] = *(const u32x4*)(ss + (size_t)r_ * 256 + col0 + bj * 128); \
                r0[bf_][bj] = *(const u32x4*)(xbb + (size_t)k_ * D + bj * 128); r1[bf_][bj] = *(const u32x4*)(xbb + (size_t)km_ * D + bj * 128); } } while (0)
        SD_LOAD(0, 0);
#pragma unroll
        for (int it = 0; it < 8; ++it) {
            const int ai = it >> 2, m = it & 3, bf = it & 1;
            const int r = row0 + ai * 128 + m * 16, k = 256 * kt + r, km = (k == 0) ? 0 : SEQ - k;
            if (it + 1 < 8) SD_LOAD(bf ^ 1, it + 1);
#pragma unroll
            for (int bj = 0; bj < 2; ++bj) {
                const u32x4 swv = sw[bf][bj];
                const f32x4 s0 = (f32x4){bf_lo(swv.x), bf_hi(swv.x), bf_lo(swv.y), bf_hi(swv.y)}, s1 = (f32x4){bf_lo(swv.z), bf_hi(swv.z), bf_lo(swv.w), bf_hi(swv.w)};
                const f32x4 d0 = acc[ai][bj][m][0], d1 = acc[ai][bj][m][1];
                { const u32x4 rr = r0[bf][bj];
                  const f32x4 v0 = (s0 + d0) + (f32x4){bf_lo(rr.x), bf_hi(rr.x), bf_lo(rr.y), bf_hi(rr.y)}, v1 = (s1 + d1) + (f32x4){bf_lo(rr.z), bf_hi(rr.z), bf_lo(rr.w), bf_hi(rr.w)};
                  u32x4 w; w.x = cvt_pk_bf16(v0[0], v0[1]); w.y = cvt_pk_bf16(v0[2], v0[3]); w.z = cvt_pk_bf16(v1[0], v1[1]); w.w = cvt_pk_bf16(v1[2], v1[3]);
                  *(u32x4*)(xbb + (size_t)k * D + bj * 128) = w;
                  u32x2 q; q.x = pk4_fp8(v0[0], v0[1], v0[2], v0[3]); q.y = pk4_fp8(v1[0], v1[1], v1[2], v1[3]); *(u32x2*)(x8b + (size_t)k * D + bj * 128) = q; }
                if (k != 0) { const u32x4 rr = r1[bf][bj];
                  const f32x4 v0 = (s0 - d0) + (f32x4){bf_lo(rr.x), bf_hi(rr.x), bf_lo(rr.y), bf_hi(rr.y)}, v1 = (s1 - d1) + (f32x4){bf_lo(rr.z), bf_hi(rr.z), bf_lo(rr.w), bf_hi(rr.w)};
                  u32x4 w; w.x = cvt_pk_bf16(v0[0], v0[1]); w.y = cvt_pk_bf16(v0[2], v0[3]); w.z = cvt_pk_bf16(v1[0], v1[1]); w.w = cvt_pk_bf16(v1[2], v1[3]);
                  *(u32x4*)(xbb + (size_t)km * D + bj * 128) = w;
                  u32x2 q; q.x = pk4_fp8(v0[0], v0[1], v0[2], v0[3]); q.y = pk4_fp8(v1[0], v1[1], v1[2], v1[3]); *(u32x2*)(x8b + (size_t)km * D + bj * 128) = q; }
            }
            asm volatile("" ::: "memory");
        }
#undef SD_LOAD
    }
};
struct OrdFfn1 {
    unsigned char* ws; int l, G, c, u0, u1;
    __device__ __forceinline__ bool next(int i, Unit& u) const {
        i += u0; if (i >= u1) return false;
        const int L = i * G + c; if (L >= 2048) return false;
        pg8::tile_of(L, 2048, 16, u.pm, u.pn);
        u.a = (const char*)(ws + WS_XS);
        u.b = (const char*)(ws + WS_WGU) + ((size_t)(l * NE + (u.pm >> 3)) * 4096 + 256 * u.pn) * D;
        return true;
    }
};
struct EpiSwiglu {
    unsigned char* ws;
    __device__ __forceinline__ const float* scales(const Unit& u) const { return (const float*)(ws + WS_SRS) + 256 * u.pm; }
    __device__ __forceinline__ void operator()(AccRef acc, const Unit& u, int wr, int wc, int fr, int fq, const LAS float* sc) const {
        unsigned char* base = ws + WS_HID + (size_t)(256 * u.pm) * D + 128 * u.pn;
        const int row0 = wr * 64 + fr, col0 = wc * 32 + 8 * fq;
#pragma unroll
        for (int ai = 0; ai < 2; ++ai)
#pragma unroll
            for (int m = 0; m < 4; ++m) {
                const int r = row0 + ai * 128 + m * 16;
                const float rs = sc[r] * (1.0f / W8_SCALE), kt = rs * -1.44269504089f, ik2 = __builtin_amdgcn_rcpf(rs * rs * H8_SCALE);
                float h[8];
#pragma unroll
                for (int n = 0; n < 2; ++n)
#pragma unroll
                    for (int j = 0; j < 4; j += 2) {
                        const f32x2 ag = (f32x2){acc[ai][0][m][n][j], acc[ai][0][m][n][j + 1]}, au = (f32x2){acc[ai][1][m][n][j], acc[ai][1][m][n][j + 1]};
                        const f32x2 t = ag * kt;
                        f32x2 d; d.x = __builtin_amdgcn_exp2f(t.x); d.y = __builtin_amdgcn_exp2f(t.y);
                        d = d * ik2 + ik2;
                        f32x2 rc; rc.x = __builtin_amdgcn_rcpf(d.x); rc.y = __builtin_amdgcn_rcpf(d.y);
                        const f32x2 hv = (ag * au) * rc;
                        h[n * 4 + j] = __builtin_amdgcn_fmed3f(hv.x, -448.f, 448.f); h[n * 4 + j + 1] = __builtin_amdgcn_fmed3f(hv.y, -448.f, 448.f);
                    }
                u32x2 w; w.x = pk4_fp8(h[0], h[1], h[2], h[3]); w.y = pk4_fp8(h[4], h[5], h[6], h[7]);
                *(u32x2*)(base + (size_t)r * D + col0) = w; }
    }
};
struct OrdFfn2 {
    unsigned char* ws; int l, G, c, u0, u1;
    __device__ __forceinline__ bool next(int i, Unit& u) const {
        i += u0; if (i >= u1) return false;
        const int L = i * G + c; if (L >= 1024) return false;
        pg8::tile_of(L, 1024, 8, u.pm, u.pn);
        u.a = (const char*)(ws + WS_HID) + (size_t)(256 * u.pm) * D;
        u.b = (const char*)(ws + WS_WD) + ((size_t)(l * NE + (u.pm >> 3)) * D + 256 * u.pn) * D;
        return true;
    }
};
struct EpiDown {
    unsigned char* ws;
    __device__ __forceinline__ const float* scales(const Unit& u) const { return (const float*)(ws + WS_SGT) + 256 * u.pm; }
    __device__ __forceinline__ void operator()(AccRef acc, const Unit& u, int wr, int wc, int fr, int fq, const LAS float* sc) const {
        unsigned char* base = ws + WS_YS + (size_t)(256 * u.pm) * D + 256 * u.pn;
        const int row0 = wr * 64 + fr, col0 = wc * 32 + 8 * fq;
#pragma unroll
        for (int ai = 0; ai < 2; ++ai)
#pragma unroll
            for (int m = 0; m < 4; ++m) {
                const int r = row0 + ai * 128 + m * 16;
                const float scl = sc[r] * (YS8_SCALE / (W8_SCALE * H8_SCALE));
#pragma unroll
                for (int bj = 0; bj < 2; ++bj) { f32x4 v0 = acc[ai][bj][m][0] * scl, v1 = acc[ai][bj][m][1] * scl;
#pragma unroll
                    for (int j = 0; j < 4; ++j) { v0[j] = __builtin_amdgcn_fmed3f(v0[j], -448.f, 448.f); v1[j] = __builtin_amdgcn_fmed3f(v1[j], -448.f, 448.f); }
                    u32x2 q; q.x = pk4_fp8(v0[0], v0[1], v0[2], v0[3]); q.y = pk4_fp8(v1[0], v1[1], v1[2], v1[3]);
                    *(u32x2*)(base + (size_t)r * D + col0 + bj * 128) = q; } }
    }
};

__device__ __forceinline__ void tr_tile(const float* W, int ldw, const float* ks, bf16* dst, int dld, int k0, int n0, int drow0, int kd0, int lane) {
    const int kr = lane >> 4, nq = lane & 15;
    const float* src = W + (size_t)(k0 + 16 * kr) * ldw + n0 + 4 * nq;
    f32x4 v[16];
#pragma unroll
    for (int i = 0; i < 16; ++i) v[i] = __builtin_nontemporal_load((const f32x4*)(src + (size_t)i * ldw));
    if (ks) {
        const f32x4* kp = (const f32x4*)(ks + k0 + 16 * kr);
#pragma unroll
        for (int i4 = 0; i4 < 4; ++i4) { const f32x4 s = kp[i4];
#pragma unroll
            for (int j = 0; j < 4; ++j) v[i4 * 4 + j] = v[i4 * 4 + j] * s[j]; }
    }
#pragma unroll
    for (int j = 0; j < 4; ++j) {
        bf16* o = dst + (size_t)(drow0 + 4 * nq + j) * dld + kd0 + 16 * kr;
        u32x4 w0, w1;
        w0.x = cvt_pk_bf16(v[0][j], v[1][j]); w0.y = cvt_pk_bf16(v[2][j], v[3][j]); w0.z = cvt_pk_bf16(v[4][j], v[5][j]); w0.w = cvt_pk_bf16(v[6][j], v[7][j]);
        w1.x = cvt_pk_bf16(v[8][j], v[9][j]); w1.y = cvt_pk_bf16(v[10][j], v[11][j]); w1.z = cvt_pk_bf16(v[12][j], v[13][j]); w1.w = cvt_pk_bf16(v[14][j], v[15][j]);
        *(u32x4*)o = w0; *(u32x4*)(o + 8) = w1;
    }
}
struct Tr8 { const float* wg; const float* wu; const float* wd; const float* g2; unsigned char* ws; LAS unsigned char* lds; int wave, lane; };
__device__ __forceinline__ void tr8_load(const Tr8& T, int lw, int it, f32x4 (&v)[16], f32x4 (&kq)[4]) {
    const int mid = it >> 7, r = it & 127, n0 = (r & 7) * 256, k0 = (r >> 3) * 128, le = lw * 16 + (mid & 15), kind = mid >> 4;
    { const float* ks = T.g2 + (le >> 4) * D + k0 + 16 * T.wave;
#pragma unroll
      for (int q = 0; q < 4; ++q) kq[q] = (kind < 2) ? *(const f32x4*)(ks + 4 * q) : (f32x4){1.f, 1.f, 1.f, 1.f}; }
    const float* src = (kind == 0 ? T.wg : kind == 1 ? T.wu : T.wd) + (size_t)le * D * D + (size_t)(k0 + 16 * T.wave) * D + n0 + 4 * T.lane;
#pragma unroll
    for (int i = 0; i < 16; ++i) v[i] = __builtin_nontemporal_load((const f32x4*)(src + (size_t)i * D));
}
__device__ __forceinline__ void tr8_proc(const Tr8& T, int lw, int it, f32x4 (&v)[16], const f32x4 (&kq)[4], int p) {
    constexpr int PITCH = 144, IMG = 256 * PITCH;
    const int mid = it >> 7, r = it & 127, n0 = (r & 7) * 256, k0 = (r >> 3) * 128, le = lw * 16 + (mid & 15), kind = mid >> 4;
#pragma unroll
    for (int i = 0; i < 16; ++i) v[i] = v[i] * (kq[i >> 2][i & 3] * W8_SCALE);
    LAS unsigned char* img = T.lds + p * IMG;
#pragma unroll
    for (int j = 0; j < 4; ++j) { u32x4 w;
        w.x = pk4_fp8(v[0][j], v[1][j], v[2][j], v[3][j]); w.y = pk4_fp8(v[4][j], v[5][j], v[6][j], v[7][j]);
        w.z = pk4_fp8(v[8][j], v[9][j], v[10][j], v[11][j]); w.w = pk4_fp8(v[12][j], v[13][j], v[14][j], v[15][j]);
        *(LAS u32x4*)(img + (4 * T.lane + j) * PITCH + 16 * T.wave) = w; }
    asm volatile("s_waitcnt lgkmcnt(0)" ::: "memory"); __builtin_amdgcn_s_barrier(); asm volatile("" ::: "memory");
    unsigned char* dst = (kind < 2) ? T.ws + WS_WGU + (size_t)le * 4096 * D : T.ws + WS_WD + (size_t)le * D * D;
#pragma unroll
    for (int q = 0; q < 4; ++q) {
        const int row = 32 * T.wave + 8 * q + (T.lane >> 3), ch = T.lane & 7, n = n0 + row;
        const int drow = (kind < 2) ? ((n >> 7) * 256 + (n & 127) + (kind == 1 ? 128 : 0)) : n;
        const u32x4 w = *(const LAS u32x4*)(img + row * PITCH + 16 * ch);
        __builtin_nontemporal_store(w, (u32x4*)(dst + (size_t)drow * D + k0 + 16 * ch)); }
}
__device__ __forceinline__ void p_conv(Frame& F, int j0, int j1) {
    const Tr8 T{F.w_g, F.w_u, F.w_d, F.g2, F.ws, F.lds, F.wave, F.lane};
    f32x4 va[16], vb[16], ka[4], kb[4];
    int j = j0, p = 0;
#define CV_LW(j_) ((j_) >= 24 ? 1 : 0)
#define CV_IT(j_) (((j_) - 24 * CV_LW(j_)) * F.G + F.bx)
    if (j < j1) tr8_load(T, CV_LW(j), CV_IT(j), va, ka);
    while (j < j1) {
        const int j2 = j + 1; if (j2 < j1) tr8_load(T, CV_LW(j2), CV_IT(j2), vb, kb);
        tr8_proc(T, CV_LW(j), CV_IT(j), va, ka, p); p ^= 1;
        if (j2 >= j1) break;
        const int j3 = j2 + 1; if (j3 < j1) tr8_load(T, CV_LW(j3), CV_IT(j3), va, ka);
        tr8_proc(T, CV_LW(j2), CV_IT(j2), vb, kb, p); p ^= 1;
        j = j3;
    }
    __syncthreads();
#undef CV_LW
#undef CV_IT
}
__device__ __forceinline__ void add8_fp8(f32x4 (&v)[2], u32x2 w, float sc) {
    const f32x2 a = __builtin_amdgcn_cvt_pk_f32_fp8((int)w.x, false), b = __builtin_amdgcn_cvt_pk_f32_fp8((int)w.x, true), c = __builtin_amdgcn_cvt_pk_f32_fp8((int)w.y, false), d = __builtin_amdgcn_cvt_pk_f32_fp8((int)w.y, true);
    v[0] = v[0] + (f32x4){a.x, a.y, b.x, b.y} * sc; v[1] = v[1] + (f32x4){c.x, c.y, d.x, d.y} * sc;
}
__device__ __forceinline__ void row_pass(Frame& F, int row, bool from_x, bool final_out) {
    const int lane = F.lane;
    f32x4 v[4][2];
    if (from_x) { const float* sp = F.x + (size_t)row * D + 8 * lane;
#pragma unroll
        for (int j = 0; j < 4; ++j) { v[j][0] = *(const f32x4*)(sp + 512 * j); v[j][1] = *(const f32x4*)(sp + 512 * j + 4); } }
    else {
        const int* sel = (const int*)(F.ws + WS_SEL) + (size_t)row * NE;
        const int sv = (lane < NE) ? sel[lane] : -1;
        const bf16* bp = (const bf16*)(F.ws + WS_XB) + (size_t)row * D + 8 * lane;
#pragma unroll
        for (int j = 0; j < 4; ++j) { const u32x4 w = *(const u32x4*)(bp + 512 * j);
            v[j][0] = (f32x4){bf_lo(w.x), bf_hi(w.x), bf_lo(w.y), bf_hi(w.y)}; v[j][1] = (f32x4){bf_lo(w.z), bf_hi(w.z), bf_lo(w.w), bf_hi(w.w)}; }
        unsigned long long m = __ballot(sv >= 0);
        const int b = row >> 12;
        const unsigned char* ybase = F.ws + WS_YS + (size_t)(b * CAP) * D + 8 * lane;
        while (m) {
            const int e0 = __builtin_ctzll(m); m &= m - 1;
            const bool two = (m != 0ull);
            const int e1 = two ? __builtin_ctzll(m) : e0; if (two) m &= m - 1;
            const int s0 = __builtin_amdgcn_readlane(sv, e0), s1 = __builtin_amdgcn_readlane(sv, e1);
            const unsigned char* y0 = ybase + ((size_t)e0 * ESL + s0) * D; const unsigned char* y1 = ybase + ((size_t)e1 * ESL + s1) * D;
            u32x2 w0[4], w1[4];
#pragma unroll
            for (int j = 0; j < 4; ++j) { w0[j] = *(const u32x2*)(y0 + 512 * j); w1[j] = *(const u32x2*)(y1 + 512 * j); }
#pragma unroll
            for (int j = 0; j < 4; ++j) add8_fp8(v[j], w0[j], 1.0f / YS8_SCALE);
            if (two) {
#pragma unroll
                for (int j = 0; j < 4; ++j) add8_fp8(v[j], w1[j], 1.0f / YS8_SCALE); }
        }
    }
    float ss = 0.f;
#pragma unroll
    for (int j = 0; j < 4; ++j)
#pragma unroll
        for (int h = 0; h < 2; ++h) ss += (v[j][h][0] * v[j][h][0] + v[j][h][1] * v[j][h][1]) + (v[j][h][2] * v[j][h][2] + v[j][h][3] * v[j][h][3]);
    const float inv = 1.f / sqrtf(wave_sum(ss, lane) * (1.f / D) + RMS_EPS);
    if (final_out) {
        float* op = F.out + (size_t)row * D + 8 * lane; const float* gp = F.gf + 8 * lane;
        f32x4 gq[4][2];
#pragma unroll
        for (int j = 0; j < 4; ++j) { gq[j][0] = *(const f32x4*)(gp + 512 * j); gq[j][1] = *(const f32x4*)(gp + 512 * j + 4); }
#pragma unroll
        for (int j = 0; j < 4; ++j)
#pragma unroll
            for (int h = 0; h < 2; ++h) *(f32x4*)(op + 512 * j + 4 * h) = v[j][h] * inv * gq[j][h];
    } else {
        bf16* bp = (bf16*)(F.ws + WS_XB) + (size_t)row * D + 8 * lane;
#pragma unroll
        for (int j = 0; j < 4; ++j) { u32x4 w; w.x = cvt_pk_bf16(v[j][0][0], v[j][0][1]); w.y = cvt_pk_bf16(v[j][0][2], v[j][0][3]); w.z = cvt_pk_bf16(v[j][1][0], v[j][1][1]); w.w = cvt_pk_bf16(v[j][1][2], v[j][1][3]);
            *(u32x4*)(bp + 512 * j) = w; }
        if (lane == 0) ((float*)(F.ws + WS_RMS1))[row] = inv;
    }
}
__device__ __forceinline__ bf16 f2bf(float v) { return (bf16)(cvt_pk_bf16(v, 0.f) & 0xffffu); }
__device__ __forceinline__ void p_prep(Frame& F) {
    LAS float* ctab = (LAS float*)F.lds;
    for (int i = F.tid; i < 4096; i += 512) ctab[i] = cospif((float)i * (1.0f / 2048.0f));
    __syncthreads();
    const int gt = F.bx * 512 + F.tid, NGT = F.G * 512;
    for (int i = gt; i < 512 * 256; i += NGT) {
        const int j = i >> 8, m = i & 255, ph = ((j & 255) * m) & 255;
        const float v = (j < 256) ? ctab[ph * 16] : -ctab[(ph * 16 + 3072) & 4095];
        ((bf16*)(F.ws + WS_CCS))[i] = f2bf(v * (1.0f / 1024.0f));
    }
    for (int i = gt; i < 16 * 256 * 512; i += NGT) {
        const int k1 = i >> 17, r = (i >> 9) & 255, kk = i & 511, p = r >> 7, k2 = r & 127, ri = kk >> 8, l2 = kk & 255, ph = ((k1 + 16 * k2) * l2) & 4095;
        const float c = ctab[ph], sn = ctab[(ph + 3072) & 4095], sg = (k1 <= 8) ? 1.f : -1.f;
        ((bf16*)(F.ws + WS_CS))[i] = f2bf(p == 0 ? (ri == 0 ? c : -sg * sn) : (ri == 0 ? sn : sg * c));
    }
    for (int i = gt; i < NL * 4 * 65536; i += NGT) {
        ((bf16*)(F.ws + WS_WF))[i] = f2bf(F.w_f[i]);
        const int lg = i >> 16, d = i & 255;
        ((bf16*)(F.ws + WS_WPS))[i] = f2bf(F.w_p[i] * F.p_s[lg * 256 + d]);
    }
    for (int i = gt; i < NL * NE * D; i += NGT) {
        const int l = i / (NE * D), e = (i / D) % NE, k = i % D;
        ((bf16*)(F.ws + WS_WR))[i] = f2bf(F.g2[l * D + k] * F.w_r[((size_t)l * D + k) * NE + e]);
    }
    for (int r = F.gw; r < T; r += F.NGW) row_pass(F, r, true, false);
    for (int it = F.gw; it < 4 * 1024; it += F.NGW) {
        const int mid = it >> 10, tile = it & 1023, k0 = (tile >> 5) * 64, n0 = (tile & 31) * 64;
        if (mid < 2) tr_tile(F.w_in + (size_t)mid * D * D, D, F.g1 + mid * D, (bf16*)(F.ws + WS_WIN) + (size_t)mid * D * D, D, k0, n0, n0, k0, F.lane);
        else tr_tile(F.w_out + (size_t)(mid - 2) * D * D, D, nullptr, (bf16*)(F.ws + WS_WOT) + ((size_t)(mid - 2) * 8 + (k0 >> 8)) * D * 256, 256, k0, n0, n0, k0 & 255, F.lane);
    }
}

__device__ __forceinline__ void ld8(const bf16* p, float (&o)[8]) { const u32x4 w = *(const u32x4*)p; o[0] = bf_lo(w.x); o[1] = bf_hi(w.x); o[2] = bf_lo(w.y); o[3] = bf_hi(w.y); o[4] = bf_lo(w.z); o[5] = bf_hi(w.z); o[6] = bf_lo(w.w); o[7] = bf_hi(w.w); }
template <int H, int MODE  >
__device__ __forceinline__ void pool_pass(const bf16* up, int r0, u32x4 (&pm)[8], bf16* fs, bf16* fd, float* ny, int t0) {
    u32x4 slot[8 + 2 * H];
#pragma unroll
    for (int s = 0; s < 8 + 2 * H; ++s) { const int row = r0 - H + s; slot[s] = (row >= 0 && row < SEQ) ? *(const u32x4*)(up + (size_t)row * 1024) : (u32x4){0u, 0u, 0u, 0u}; }
    float sum[8];
#pragma unroll
    for (int j = 0; j < 8; ++j) sum[j] = 0.f;
#pragma unroll
    for (int s = 0; s < 2 * H; ++s) { const u32x4 w = slot[s];
        sum[0] += bf_lo(w.x); sum[1] += bf_hi(w.x); sum[2] += bf_lo(w.y); sum[3] += bf_hi(w.y); sum[4] += bf_lo(w.z); sum[5] += bf_hi(w.z); sum[6] += bf_lo(w.w); sum[7] += bf_hi(w.w); }
#pragma unroll
    for (int i = 0; i < (MODE == 2 ? 1 : 8); ++i) {
        const int t = r0 + i;
        const int lo = (t - H) < 0 ? 0 : (t - H), hi = (t + H) > SEQ ? SEQ : (t + H);
        const float rc = (t < SEQ) ? 1.0f / (float)(hi - lo) : 0.f;
        u32x4 c = slot[i + H]; asm volatile("" : "+v"(c));
        const float cv[8] = {bf_lo(c.x), bf_hi(c.x), bf_lo(c.y), bf_hi(c.y), bf_lo(c.z), bf_hi(c.z), bf_lo(c.w), bf_hi(c.w)};
        float o8[8];
#pragma unroll
        for (int j = 0; j < 8; ++j) o8[j] = (t < SEQ) ? sum[j] * rc - cv[j] : 0.f;
        if constexpr (MODE == 0) {
            pm[i].x = cvt_pk_bf16(o8[0], o8[1]); pm[i].y = cvt_pk_bf16(o8[2], o8[3]); pm[i].z = cvt_pk_bf16(o8[4], o8[5]); pm[i].w = cvt_pk_bf16(o8[6], o8[7]);
        } else if constexpr (MODE == 1) {
            const bool first = (t0 + i == 0);
            const u32x4 mw = pm[7 - i];
            const float mv[8] = {bf_lo(mw.x), bf_hi(mw.x), bf_lo(mw.y), bf_hi(mw.y), bf_lo(mw.z), bf_hi(mw.z), bf_lo(mw.w), bf_hi(mw.w)};
            float ps[8], pd[8];
#pragma unroll
            for (int q = 0; q < 8; ++q) { const float a = o8[q], m = mv[q]; ps[q] = first ? a : 0.5f * (a + m); pd[q] = first ? 0.f : 0.5f * (a - m); }
            u32x4 w; w.x = cvt_pk_bf16(ps[0], ps[1]); w.y = cvt_pk_bf16(ps[2], ps[3]); w.z = cvt_pk_bf16(ps[4], ps[5]); w.w = cvt_pk_bf16(ps[6], ps[7]);
            *(u32x4*)(fs + (size_t)i * 2048) = w;
            w.x = cvt_pk_bf16(pd[0], pd[1]); w.y = cvt_pk_bf16(pd[2], pd[3]); w.z = cvt_pk_bf16(pd[4], pd[5]); w.w = cvt_pk_bf16(pd[6], pd[7]);
            *(u32x4*)(fd + (size_t)i * 2048) = w;
        } else { *(f32x4*)ny = (f32x4){o8[0], o8[1], o8[2], o8[3]}; *(f32x4*)(ny + 4) = (f32x4){o8[4], o8[5], o8[6], o8[7]}; }
        if (i < 7 && MODE != 2) { const u32x4 a = slot[i + 2 * H]; u32x4 d = slot[i]; asm volatile("" : "+v"(d));
            sum[0] += bf_lo(a.x) - bf_lo(d.x); sum[1] += bf_hi(a.x) - bf_hi(d.x); sum[2] += bf_lo(a.y) - bf_lo(d.y); sum[3] += bf_hi(a.y) - bf_hi(d.y);
            sum[4] += bf_lo(a.z) - bf_lo(d.z); sum[5] += bf_hi(a.z) - bf_hi(d.z); sum[6] += bf_lo(a.w) - bf_lo(d.w); sum[7] += bf_hi(a.w) - bf_hi(d.w); }
    }
}
template <int H>
__device__ __forceinline__ void pool_item(unsigned char* ws, int b, int c, int chunk) {
    const int t0 = chunk * 8;
    const bf16* up = (const bf16*)(ws + WS_UP) + (size_t)b * SEQ * 1024 + c;
    bf16* fs = (bf16*)(ws + WS_F) + ((size_t)b * KH + t0) * 2048 + 1024 + c; bf16* fd = fs + (size_t)NB * KH * 2048;
    float* ny = (float*)(ws + WS_NY) + (size_t)b * 2048 + 1024 + c;
    u32x4 pmr[8];
    pool_pass<H, 0>(up, SEQ - t0 - 7, pmr, fs, fd, ny, t0);
    asm volatile("" ::: "memory");
    pool_pass<H, 1>(up, t0, pmr, fs, fd, ny, t0);
    asm volatile("" ::: "memory");
    if (chunk == 255) pool_pass<H, 2>(up, 2048, pmr, fs, fd, ny, t0);
}
__device__ __forceinline__ void p_pool(Frame& F) {
    for (int it = F.wave * F.G + F.bx; it < 2048; it += F.NGW) {
        const int b = it >> 9, g = (it >> 7) & 3, chunk = 2 * (it & 127) + (F.lane >> 5), c = 256 * g + 8 * (F.lane & 31);
        switch (g) {
            case 0: pool_item<1>(F.ws, b, c, chunk); break;
            case 1: pool_item<2>(F.ws, b, c, chunk); break;
            case 2: pool_item<4>(F.ws, b, c, chunk); break;
            default: pool_item<8>(F.ws, b, c, chunk); break;
        }
    }
}

__device__ __forceinline__ void p_fft1(Frame& F) {
    constexpr float C16[16] = {1.f, 0.92387953251f, 0.70710678119f, 0.38268343236f, 0.f, -0.38268343236f, -0.70710678119f, -0.92387953251f, -1.f, -0.92387953251f, -0.70710678119f, -0.38268343236f, 0.f, 0.38268343236f, 0.70710678119f, 0.92387953251f};
    for (int it = F.bx * 512 + F.tid; it < NB * 1024 * 64; it += F.G * 512) {
        const int j4 = it & 63, bc = it >> 6, b = bc >> 10, c = bc & 1023, l2 = 4 * j4;
        const bf16* up = (const bf16*)(F.ws + WS_UT) + (size_t)bc * SEQ + l2;
        f32x4 x[16];
#pragma unroll
        for (int l1 = 0; l1 < 16; ++l1) { const u32x2 w = *(const u32x2*)(up + 256 * l1); x[l1] = (f32x4){bf_lo(w.x), bf_hi(w.x), bf_lo(w.y), bf_hi(w.y)}; }
        {
            float ny = 0.f;
#pragma unroll
            for (int l1 = 0; l1 < 16; ++l1) ny += (x[l1][0] - x[l1][1]) + (x[l1][2] - x[l1][3]);
            ny = wave_sum(ny, F.lane);
            if (F.lane == 0) ((float*)(F.ws + WS_NY))[(size_t)b * 2048 + c] = ny;
        }
        f32x4 t0[4], t1r[4], t1s[4], t2[4];
#pragma unroll
        for (int bp = 0; bp < 4; ++bp) { const f32x4 e = x[bp] + x[8 + bp], o = x[4 + bp] + x[12 + bp]; t0[bp] = e + o; t2[bp] = e - o; t1r[bp] = x[bp] - x[8 + bp]; t1s[bp] = x[4 + bp] - x[12 + bp]; }
        bf16* zp = (bf16*)(F.ws + WS_ZT) + (((size_t)(b * 9) * 1024 + c) * 2) * 256 + l2;
#pragma unroll
        for (int k1 = 0; k1 <= 8; ++k1) {
            const int q = k1 & 3;
            f32x4 yr = (f32x4){0.f, 0.f, 0.f, 0.f}, ys = yr;
#pragma unroll
            for (int bp = 0; bp < 4; ++bp) {
                const float ca = C16[(k1 * bp) & 15], sa = C16[((k1 * bp) + 12) & 15];
                const f32x4 tr = (q == 0) ? t0[bp] : (q == 2) ? t2[bp] : t1r[bp];
                if (q & 1) { const f32x4 ts = (q == 1) ? t1s[bp] : (f32x4){0.f, 0.f, 0.f, 0.f} - t1s[bp];
                    yr = yr + tr * ca - ts * sa; ys = ys + tr * sa + ts * ca; }
                else { yr = yr + tr * ca; ys = ys + tr * sa; }
            }
            u32x2 w0, w1;
            w0.x = cvt_pk_bf16(yr[0], yr[1]); w0.y = cvt_pk_bf16(yr[2], yr[3]); w1.x = cvt_pk_bf16(ys[0], ys[1]); w1.y = cvt_pk_bf16(ys[2], ys[3]);
            bf16* o = zp + (size_t)k1 * (1024 * 512);
            *(u32x2*)o = w0; *(u32x2*)(o + 256) = w1;
        }
    }
}

__device__ __forceinline__ void p_row2048(Frame& F, int l) {
    const int gwi = F.wave * F.G + F.bx;
    if (gwi >= NB * 512) return;
    const int b = gwi >> 9, n0 = (gwi & 511) * 4;
    const float* ny = (const float*)(F.ws + WS_NY) + (size_t)b * 2048 + 8 * F.lane;
    f32x4 a[4][2];
#pragma unroll
    for (int i = 0; i < 4; ++i) { a[i][0] = *(const f32x4*)(ny + 512 * i); a[i][1] = *(const f32x4*)(ny + 512 * i + 4); }
    const bf16* wrow = (const bf16*)(F.ws + WS_WO2) + ((size_t)(l * 2) * D + n0) * 2048 + 8 * F.lane;
    bf16* xb = (bf16*)(F.ws + WS_XB) + (size_t)(b * SEQ + 2048) * D + n0; unsigned char* x8 = F.ws + WS_XS + (size_t)(b * SEQ + 2048) * D + n0;
    const u32x2 xr = *(const u32x2*)xb;
    const float xres[4] = {bf_lo(xr.x), bf_hi(xr.x), bf_lo(xr.y), bf_hi(xr.y)};
    u32x4 wv[4][4];
#pragma unroll
    for (int j = 0; j < 4; ++j)
#pragma unroll
        for (int i = 0; i < 4; ++i) wv[j][i] = *(const u32x4*)(wrow + (size_t)j * 2048 + 512 * i);
    float dv[4];
#pragma unroll
    for (int j = 0; j < 4; ++j) {
        float d = 0.f;
#pragma unroll
        for (int i = 0; i < 4; ++i) { const u32x4 q = wv[j][i];
            d += (a[i][0][0] * bf_lo(q.x) + a[i][0][1] * bf_hi(q.x)) + (a[i][0][2] * bf_lo(q.y) + a[i][0][3] * bf_hi(q.y)) + (a[i][1][0] * bf_lo(q.z) + a[i][1][1] * bf_hi(q.z)) + (a[i][1][2] * bf_lo(q.w) + a[i][1][3] * bf_hi(q.w)); }
        dv[j] = wave_sum(d, F.lane);
    }
    if (F.lane == 0) {
#pragma unroll
        for (int j = 0; j < 4; ++j) { const float v = dv[j] + xres[j]; xb[j] = f2bf(v); x8[j] = (unsigned char)(pk4_fp8(v, 0.f, 0.f, 0.f) & 0xffu); }
    }
}

__device__ __forceinline__ void p_router(Frame& F, int l) {
    const int fr = F.lane & 15, fq = F.lane >> 4;
    for (int it = F.wave * F.G + F.bx; it < T / 16; it += F.NGW) {
        const int tok0 = it * 16;
        const bf16* xp = (const bf16*)(F.ws + WS_XB) + (size_t)(tok0 + fr) * D + 8 * fq;
        const bf16* wp = (const bf16*)(F.ws + WS_WR) + (size_t)l * NE * D + (size_t)fr * D + 8 * fq;
        f32x4 acc = (f32x4){0.f, 0.f, 0.f, 0.f}; float ss = 0.f;
#pragma unroll 16
        for (int ks = 0; ks < D / 32; ++ks) {
            const u32x4 xa = *(const u32x4*)(xp + 32 * ks); const u32x4 wb = *(const u32x4*)(wp + 32 * ks);
            ss += bf_lo(xa.x) * bf_lo(xa.x) + bf_hi(xa.x) * bf_hi(xa.x) + bf_lo(xa.y) * bf_lo(xa.y) + bf_hi(xa.y) * bf_hi(xa.y)
                + bf_lo(xa.z) * bf_lo(xa.z) + bf_hi(xa.z) * bf_hi(xa.z) + bf_lo(xa.w) * bf_lo(xa.w) + bf_hi(xa.w) * bf_hi(xa.w);
            acc = __builtin_amdgcn_mfma_f32_16x16x32_bf16(__builtin_bit_cast(bf16x8, wb), __builtin_bit_cast(bf16x8, xa), acc, 0, 0, 0);
        }
        ss += shx(ss, 16, F.lane); ss += shx(ss, 32, F.lane);
        const float inv = 1.f / sqrtf(ss * (1.f / D) + RMS_EPS);
        float z[4], mx;
#pragma unroll
        for (int j = 0; j < 4; ++j) z[j] = acc[j] * inv;
        mx = fmaxf(fmaxf(z[0], z[1]), fmaxf(z[2], z[3])); mx = fmaxf(mx, shx(mx, 16, F.lane)); mx = fmaxf(mx, shx(mx, 32, F.lane));
        float sm = 0.f;
#pragma unroll
        for (int j = 0; j < 4; ++j) { z[j] = __expf(z[j] - mx); sm += z[j]; }
        sm += shx(sm, 16, F.lane); sm += shx(sm, 32, F.lane);
        const float rsm = 1.f / sm;
        const int tok = tok0 + fr, b = tok >> 12, t = tok & 4095;
        float* pp = (float*)(F.ws + WS_PROB) + ((size_t)b * NE + 4 * fq) * SEQ + t;
#pragma unroll
        for (int j = 0; j < 4; ++j) pp[(size_t)j * SEQ] = z[j] * rsm;
        if (fq == 0) ((float*)(F.ws + WS_RMS2))[tok] = inv;
    }
}

__device__ __forceinline__ void p_topk(Frame& F, int l) {
    if (F.bx >= NB * NE) return;
    const int b = F.bx >> 4, e = F.bx & 15, tid = F.tid, lane = F.lane, wave = F.wave;
    LAS unsigned* red = (LAS unsigned*)F.lds;
    const float* pp = (const float*)(F.ws + WS_PROB) + ((size_t)b * NE + e) * SEQ + 8 * tid;
    unsigned key[8];
    float rv[8];
    { const float* r2p = (const float*)(F.ws + WS_RMS2) + (size_t)b * SEQ + 8 * tid; const f32x4 ra = *(const f32x4*)r2p, rb = *(const f32x4*)(r2p + 4);
      const u32x4 a = *(const u32x4*)pp, c = *(const u32x4*)(pp + 4); key[0] = a.x; key[1] = a.y; key[2] = a.z; key[3] = a.w; key[4] = c.x; key[5] = c.y; key[6] = c.z; key[7] = c.w;
      rv[0] = ra[0]; rv[1] = ra[1]; rv[2] = ra[2]; rv[3] = ra[3]; rv[4] = rb[0]; rv[5] = rb[1]; rv[6] = rb[2]; rv[7] = rb[3]; }
    unsigned thr = 0u;
    int itn = 0;
    for (int hi = 30; hi >= 0; hi -= 2, ++itn) {
        const bool pair = (hi >= 1);
        const unsigned bh = 1u << hi, bl = pair ? (1u << (hi - 1)) : 0u;
        const unsigned c10 = thr | bh, c11 = thr | bh | bl, c01 = thr | bl;
        unsigned n10 = 0, n11 = 0, n01 = 0;
#pragma unroll
        for (int j = 0; j < 8; ++j) { n10 += (unsigned)__popcll(__ballot(key[j] >= c10)); n11 += (unsigned)__popcll(__ballot(key[j] >= c11)); n01 += (unsigned)__popcll(__ballot(key[j] >= c01)); }
        LAS unsigned* slot = red + (itn & 1) * 24;
        if (lane == 0) { slot[wave] = n10; slot[8 + wave] = n11; slot[16 + wave] = n01; }
        __syncthreads();
        unsigned t10 = 0, t11 = 0, t01 = 0;
#pragma unroll
        for (int w = 0; w < 8; ++w) { t10 += slot[w]; t11 += slot[8 + w]; t01 += slot[16 + w]; }
        if (pair) thr = (t11 >= (unsigned)CAP) ? c11 : (t10 >= (unsigned)CAP) ? c10 : (t01 >= (unsigned)CAP) ? c01 : thr;
        else      thr = (t10 >= (unsigned)CAP) ? c10 : thr;
    }
    __syncthreads();
    unsigned cg = 0, ce = 0;
#pragma unroll
    for (int j = 0; j < 8; ++j) { cg += (key[j] > thr) ? 1u : 0u; ce += (key[j] == thr) ? 1u : 0u; }
    const unsigned pk = cg | (ce << 16); unsigned inc = pk;
#pragma unroll
    for (int o = 1; o < 64; o <<= 1) { const unsigned v = (unsigned)__builtin_amdgcn_ds_bpermute((lane - o) << 2, (int)inc); if (lane >= o) inc += v; }
    LAS unsigned* wtot = red + 64;
    if (lane == 63) wtot[wave] = inc;
    __syncthreads();
    unsigned base = 0, total = 0;
#pragma unroll
    for (int w = 0; w < 8; ++w) { const unsigned v = wtot[w]; if (w < wave) base += v; total += v; }
    const unsigned excl = base + inc - pk;
    unsigned pg = excl & 0xffffu, pe = excl >> 16;
    const unsigned ngt = total & 0xffffu, need_eq = (unsigned)CAP - ngt;
    unsigned* roff = (unsigned*)(F.ws + WS_ROFF) + ((size_t)l * NE + e) * ESL + b * CAP;
    float* srs = (float*)(F.ws + WS_SRS) + (size_t)e * ESL + b * CAP;
    float* sgt = (float*)(F.ws + WS_SGT) + (size_t)e * ESL + b * CAP;
    int* sel = (int*)(F.ws + WS_SEL) + ((size_t)b * SEQ + 8 * tid) * NE + e;
#pragma unroll
    for (int j = 0; j < 8; ++j) {
        int s = -1;
        if (key[j] > thr) { s = (int)pg; ++pg; }
        else if (key[j] == thr) { if (pe < need_eq) s = (int)(ngt + pe); ++pe; }
        sel[(size_t)j * NE] = s;
        if (s >= 0) { roff[s] = (unsigned)((b * SEQ + 8 * tid + j) * D); srs[s] = rv[j]; sgt[s] = __builtin_bit_cast(float, key[j]); }
    }
    __syncthreads();
}

struct RowIn { u32x4 xw[4]; u32x2 ya[4], yb[4]; int sv, e0, e1; unsigned long long rest; bool any, two; };
__device__ __forceinline__ int comb_sv(const Frame& F, int row) { const int* sel = (const int*)(F.ws + WS_SEL) + (size_t)row * NE; return (F.lane < NE) ? sel[F.lane] : -1; }
__device__ __forceinline__ void comb_load(const Frame& F, int row, int sv, RowIn& R) {
    R.sv = sv;
    const bf16* bp = (const bf16*)(F.ws + WS_XB) + (size_t)row * D + 8 * F.lane;
#pragma unroll
    for (int j = 0; j < 4; ++j) R.xw[j] = *(const u32x4*)(bp + 512 * j);
    unsigned long long m = __ballot(sv >= 0);
    R.any = (m != 0ull);
    const int e0 = R.any ? __builtin_ctzll(m) : 0; m &= m - 1;
    R.two = (m != 0ull);
    const int e1 = R.two ? __builtin_ctzll(m) : e0; if (R.two) m &= m - 1;
    R.e0 = e0; R.e1 = e1; R.rest = m;
    if (R.any) {
        const int b = row >> 12;
        const unsigned char* ybase = F.ws + WS_YS + (size_t)(b * CAP) * D + 8 * F.lane;
        const int s0 = __builtin_amdgcn_readlane(sv, e0), s1 = __builtin_amdgcn_readlane(sv, e1);
        const unsigned char* y0 = ybase + ((size_t)e0 * ESL + s0) * D; const unsigned char* y1 = ybase + ((size_t)e1 * ESL + s1) * D;
#pragma unroll
        for (int j = 0; j < 4; ++j) { R.ya[j] = *(const u32x2*)(y0 + 512 * j); R.yb[j] = *(const u32x2*)(y1 + 512 * j); }
    } else {
#pragma unroll
        for (int j = 0; j < 4; ++j) { R.ya[j] = (u32x2){0u, 0u}; R.yb[j] = (u32x2){0u, 0u}; }
    }
}
__device__ __forceinline__ void comb_proc(Frame& F, int row, const RowIn& R, bool final_out) {
    const int lane = F.lane;
    f32x4 v[4][2];
#pragma unroll
    for (int j = 0; j < 4; ++j) { const u32x4 w = R.xw[j];
        v[j][0] = (f32x4){bf_lo(w.x), bf_hi(w.x), bf_lo(w.y), bf_hi(w.y)}; v[j][1] = (f32x4){bf_lo(w.z), bf_hi(w.z), bf_lo(w.w), bf_hi(w.w)}; }
    if (R.any) {
#pragma unroll
        for (int j = 0; j < 4; ++j) add8_fp8(v[j], R.ya[j], 1.0f / YS8_SCALE);
        if (R.two) {
#pragma unroll
            for (int j = 0; j < 4; ++j) add8_fp8(v[j], R.yb[j], 1.0f / YS8_SCALE); }
    }
    const int sv = R.sv;
    unsigned long long m = R.rest;
    const int b = row >> 12;
    const unsigned char* ybase = F.ws + WS_YS + (size_t)(b * CAP) * D + 8 * lane;
    while (m) {
        const int e0 = __builtin_ctzll(m); m &= m - 1;
        const bool two = (m != 0ull);
        const int e1 = two ? __builtin_ctzll(m) : e0; if (two) m &= m - 1;
        const int s0 = __builtin_amdgcn_readlane(sv, e0), s1 = __builtin_amdgcn_readlane(sv, e1);
        const unsigned char* y0 = ybase + ((size_t)e0 * ESL + s0) * D; const unsigned char* y1 = ybase + ((size_t)e1 * ESL + s1) * D;
        u32x2 w0[4], w1[4];
#pragma unroll
        for (int j = 0; j < 4; ++j) { w0[j] = *(const u32x2*)(y0 + 512 * j); w1[j] = *(const u32x2*)(y1 + 512 * j); }
#pragma unroll
        for (int j = 0; j < 4; ++j) add8_fp8(v[j], w0[j], 1.0f / YS8_SCALE);
        if (two) {
#pragma unroll
            for (int j = 0; j < 4; ++j) add8_fp8(v[j], w1[j], 1.0f / YS8_SCALE); }
    }
    float ss = 0.f;
#pragma unroll
    for (int j = 0; j < 4; ++j)
#pragma unroll
        for (int h = 0; h < 2; ++h) ss += (v[j][h][0] * v[j][h][0] + v[j][h][1] * v[j][h][1]) + (v[j][h][2] * v[j][h][2] + v[j][h][3] * v[j][h][3]);
    const float inv = 1.f / sqrtf(wave_sum(ss, lane) * (1.f / D) + RMS_EPS);
    if (final_out) {
        float* op = F.out + (size_t)row * D + 8 * lane; const float* gp = F.gf + 8 * lane;
        f32x4 gq[4][2];
#pragma unroll
        for (int j = 0; j < 4; ++j) { gq[j][0] = *(const f32x4*)(gp + 512 * j); gq[j][1] = *(const f32x4*)(gp + 512 * j + 4); }
#pragma unroll
        for (int j = 0; j < 4; ++j)
#pragma unroll
            for (int h = 0; h < 2; ++h) *(f32x4*)(op + 512 * j + 4 * h) = v[j][h] * inv * gq[j][h];
    } else {
        bf16* bp = (bf16*)(F.ws + WS_XB) + (size_t)row * D + 8 * lane;
#pragma unroll
        for (int j = 0; j < 4; ++j) { u32x4 w; w.x = cvt_pk_bf16(v[j][0][0], v[j][0][1]); w.y = cvt_pk_bf16(v[j][0][2], v[j][0][3]); w.z = cvt_pk_bf16(v[j][1][0], v[j][1][1]); w.w = cvt_pk_bf16(v[j][1][2], v[j][1][3]);
            *(u32x4*)(bp + 512 * j) = w; }
        if (lane == 0) ((float*)(F.ws + WS_RMS1))[row] = inv;
    }
}
__device__ __forceinline__ void p_combine(Frame& F, bool final_out) {
    RowIn A, B;
    int r = F.wave * F.G + F.bx;
    int svA = (r < T) ? comb_sv(F, r) : -1;
    int svB = (r + F.NGW < T) ? comb_sv(F, r + F.NGW) : -1;
    if (r < T) comb_load(F, r, svA, A);
    while (r < T) {
        const int r2 = r + F.NGW, r3 = r2 + F.NGW, r4 = r3 + F.NGW;
        svA = (r3 < T) ? comb_sv(F, r3) : -1;
        if (r2 < T) comb_load(F, r2, svB, B);
        comb_proc(F, r, A, final_out);
        if (r2 >= T) break;
        svB = (r4 < T) ? comb_sv(F, r4) : -1;
        if (r3 < T) comb_load(F, r3, svA, A);
        comb_proc(F, r2, B, final_out);
        r = r3;
    }
}

constexpr int PPL = 8, N_PHASES = 1 + PPL * NL;
__global__ void __launch_bounds__(512, 2) fwd(Args args) {
    extern __shared__ __attribute__((aligned(16))) unsigned char lds_raw[];
    Frame F;
    F.lds = (LAS unsigned char*)lds_raw;
    F.tid = 0; F.lane = 0; F.wave = __builtin_amdgcn_readfirstlane(threadIdx.x >> 6);
    F.G = gridDim.x; F.gw = blockIdx.x * 8 + F.wave; F.NGW = F.G * 8;
    F.x = args.in[0]; F.g1 = args.in[1]; F.w_in = args.in[2]; F.w_f = args.in[3]; F.w_p = args.in[4]; F.p_s = args.in[5]; F.w_out = args.in[6];
    F.g2 = args.in[7]; F.w_r = args.in[8]; F.w_g = args.in[9]; F.w_u = args.in[10]; F.w_d = args.in[11]; F.gf = args.in[12];
    F.out = args.out; F.ws = args.ws;
    volatile LAS unsigned* misc = (volatile LAS unsigned*)(F.lds + MISC_OFF);
    if (threadIdx.x < 64) misc[threadIdx.x] = 0u;
    __syncthreads();
    unsigned* barw = (unsigned*)(F.ws + WS_CTL) + CW_BAR;
    XcdBarrier bar; bar.bar = barw; bar.x = 0; bar.st = nullptr;
    if (!MK_PER_PHASE) bar = xcd_barrier_post(barw, misc + 8);
    const int lo = args.ph_lo, hi = args.ph_hi;
#if MK_PER_PHASE
#define IN(k) (lo <= (k) && (k) < hi)
#else
#define IN(k) true
#endif
#define SEAM(k, mn_) do { if (IN(k) && IN((k) + 1)) { int wv_ = F.wave; asm volatile("" : "+s"(wv_)); const bool mem_ = xcd_barrier_arrive(bar, wv_, (unsigned)nbar); \
        if (SHADOW && mem_ && cvn >= (mn_) && cvn < 48) { LAUNDER; p_conv(Fp, cvn, cvn + 1); ++cvn; } \
        xcd_barrier_finish(bar, wv_, (unsigned)nbar); ++nbar; } } while (0)
    LAS unsigned char* ring = F.lds;
    F.bx = (int)blockIdx.x;

#define RLOOP(bit) _Pragma("nounroll") for (int rep_ = 0; rep_ < ((REP & (bit)) ? 2 : 1); ++rep_)
#define LAUNDER Frame Fp = F; { unsigned long long z_ = 0ull; asm volatile("" : "+s"(z_)); Fp.ws = F.ws + z_; }     asm volatile("" : "+s"(Fp.wave)); asm volatile("" : "+s"(Fp.bx)); Fp.gw = Fp.bx * 8 + Fp.wave; asm volatile("v_mbcnt_lo_u32_b32 %0, -1, 0\n\tv_mbcnt_hi_u32_b32 %0, -1, %0" : "=v"(Fp.lane)); Fp.tid = Fp.wave * 64 + Fp.lane
    RLOOP(1) if (IN(0)) { LAUNDER; p_prep(Fp); __syncthreads(); }
    int nbar = 0;
    int cvn = 0;
    SEAM(0, 0);
#define PHASEG(ng_, nu_, j0_, j1_, ...) { const int grp_ = (F.bx >> 3) % (ng_); const bool cv_ = cvn < (j1_); const int split_ = cv_ ? (grp_ * (nu_) * 2 + ((ng_) - 1)) / (2 * ((ng_) - 1)) : (nu_); \
    _Pragma("nounroll") for (int s_ = 0; s_ < 2; ++s_) { const int u0_ = s_ ? split_ : 0, u1_ = s_ ? (nu_) : split_; \
        if (u1_ > u0_) { __VA_ARGS__ } \
        if (s_ == 0 && cv_) { LAUNDER; p_conv(Fp, cvn, j1_); cvn = (j1_); } } }
#pragma nounroll
    for (int l = 0; l < NL; ++l) {
        const int pb = 1 + PPL * l;
        const int cW0 = l ? 28 : 0, cW1 = l ? 33 : 6, cO0 = l ? 33 : 6, cO1 = l ? 40 : 16, cF0 = l ? 40 : 16, cF1 = l ? 48 : 24, cG0 = 24, cG1 = l ? 24 : 28;
        if (l == 0) { LAUNDER; OrdFold S{Fp.ws, 0, F.G, Fp.bx}; EpiFold E{Fp.ws, 0}; pg8::gemm_phase<4, 512, false, false, false>(ring, Fp.wave, S, E); }
        PHASEG(3, 2, cW0, cW1, { LAUNDER; OrdWin S{Fp.ws, l, F.G, Fp.bx, u0_, u1_}; EpiWin E{Fp.ws}; pg8::gemm_phase<D / 64, D * 2, false, false, true>(ring, Fp.wave, S, E); })
        SEAM(pb + 0, l ? 24 : 0);
        if (l == 0) { LAUNDER; OrdFold S{Fp.ws, 1, F.G, Fp.bx}; EpiFold E{Fp.ws, 1}; pg8::gemm_phase<4, 512, false, false, false>(ring, Fp.wave, S, E); }
        { LAUNDER; p_fft1(Fp); p_pool(Fp); }
        SEAM(pb + 1, l ? 24 : 0);
        PHASEG(2, 1, 0, 0, { LAUNDER; OrdDft S{Fp.ws, F.G, Fp.bx, u0_, u1_}; EpiDft E{Fp.ws}; pg8::gemm_phase<8, 1024, false, false, false>(ring, Fp.wave, S, E); })
        SEAM(pb + 1, l ? 24 : 0);
        { LAUNDER; p_row2048(Fp, l); }
        PHASEG(3, 2, cO0, cO1, { LAUNDER; OrdWout S{Fp.ws, l, F.G, Fp.bx, u0_, u1_}; EpiSD E{Fp.ws, Fp.bx}; pg8::gemm_phase<KH / 64, KH * 2, false, false, false>(ring, Fp.wave, S, E); })
        SEAM(pb + 2, l ? 24 : 0);
        { LAUNDER; p_router(Fp, l); }
        SEAM(pb + 3, l ? 24 : 0);
        { LAUNDER; p_topk(Fp, l); }
        SEAM(pb + 4, l ? 40 : 16);
        PHASEG(8, 8, cF0, cF1, { LAUNDER; OrdFfn1 S{Fp.ws, l, F.G, Fp.bx, u0_, u1_}; EpiSwiglu E{Fp.ws}; pg8::gemm_phase<D / 128, D, true, true, true>(ring, Fp.wave, S, E, (const unsigned*)(Fp.ws + WS_ROFF) + (size_t)l * NE * ESL); })
        SEAM(pb + 5, l ? 48 : 24);
        PHASEG(5, 4, cG0, cG1, { LAUNDER; OrdFfn2 S{Fp.ws, l, F.G, Fp.bx, u0_, u1_}; EpiDown E{Fp.ws}; pg8::gemm_phase<D / 128, D, true, false, true>(ring, Fp.wave, S, E); })
        SEAM(pb + 6, l ? 48 : 24);
        { LAUNDER; p_combine(Fp, l == NL - 1); }
        if (l + 1 < NL) SEAM(pb + 7, 24);
    }
#undef PHASEG
#undef LAUNDER
#undef RLOOP
#undef IN
#undef SEAM
}

extern "C" void kernel_launch(void* const* d_in, const int* in_sizes, int n_in, void* d_out, int out_size, void* d_ws, size_t ws_size, hipStream_t stream) {
    static int grid = 0;
    if (grid == 0) {
        if (n_in != 13 || in_sizes[0] != T * D || out_size != T * D || ws_size < WS_END) {
            fprintf(stderr, "kernel_launch: unexpected shapes (n_in %d, in0 %d, out %d, ws %zu < %zu); nothing launched\n", n_in, n_in > 0 ? in_sizes[0] : -1, out_size, ws_size, (size_t)WS_END); grid = -1; return; }
        int dev = 0, cus = 0, per_cu = 0;
        if (hipGetDevice(&dev) != hipSuccess || hipDeviceGetAttribute(&cus, hipDeviceAttributeMultiprocessorCount, dev) != hipSuccess) { fprintf(stderr, "kernel_launch: device query failed\n"); grid = -1; return; }
        if (hipFuncSetAttribute((const void*)fwd, hipFuncAttributeMaxDynamicSharedMemorySize, LDS_BYTES) != hipSuccess) { fprintf(stderr, "kernel_launch: hipFuncSetAttribute failed\n"); grid = -1; return; }
        if (hipOccupancyMaxActiveBlocksPerMultiprocessor(&per_cu, (const void*)fwd, 512, LDS_BYTES) != hipSuccess || per_cu < 1) fprintf(stderr, "kernel_launch: occupancy query reports %d\n", per_cu);
        (void)hipGetLastError();
        grid = cus;
        if (grid > 256) grid = 256;
        grid &= ~7;
        if (grid != 256) fprintf(stderr, "kernel_launch: this kernel's unit maps assume 256 workgroups (one per CU of a 256-CU device); got %d\n", grid);
    }
    if (grid <= 0) return;
    (void)hipMemsetAsync((char*)d_ws + WS_CTL, 0, CTL_ZERO_BYTES, stream);
    Args a{};
    for (int i = 0; i < 13; ++i) a.in[i] = (const float*)d_in[i];
    a.out = (float*)d_out; a.ws = (unsigned char*)d_ws;
#if MK_PER_PHASE
    for (int p = 0; p < N_PHASES; ++p) { a.ph_lo = p; a.ph_hi = p + 1; hipLaunchKernelGGL(fwd, dim3(grid), dim3(512), LDS_BYTES, stream, a); }
#else
    a.ph_lo = 0; a.ph_hi = N_PHASES;
    hipLaunchKernelGGL(fwd, dim3(grid), dim3(512), LDS_BYTES, stream, a);
#endif
    const hipError_t le = hipPeekAtLastError();
    if (le != hipSuccess) fprintf(stderr, "kernel_launch: launch failed: %s\n", hipGetErrorName(le));
}
```
